# Optimizing an MI355X kernel written in HIP

```python
import math
import jax, jax.numpy as jnp
from jax import lax
import numpy as np

D_MODEL = 1024
BATCH = 4
SEQ = 8192
DEPTH = 1

GRID_W = 64
DA_HEADS = 4
DA_HEAD_DIM = 64
DA_V_DIM = 2 * DA_HEAD_DIM
DA_WIDTH = DA_HEADS * DA_V_DIM
Q_BLOCK = 128
ROPE_THETA = 10000.0
NA_HEADS = 8
NA_HEAD_DIM = 64
NA_WIDTH = NA_HEADS * NA_HEAD_DIM
NA_KH_MAX = 8
NA_KW = 16
N_BRANCHES = 2
IN_COLS = 3 * DA_WIDTH + 3 * NA_WIDTH + N_BRANCHES * D_MODEL
IN_SPLITS = (DA_WIDTH, 2 * DA_WIDTH, 3 * DA_WIDTH,
             3 * DA_WIDTH + NA_WIDTH, 3 * DA_WIDTH + 2 * NA_WIDTH,
             3 * DA_WIDTH + 3 * NA_WIDTH)
N_EXPERTS = 32
TOP_K = 4
D_EXPERT = 1024
SWIGLU_ALPHA = 1.702
SWIGLU_LIMIT = 7.0
MOE_BLOCK = 256
LN_EPS = 1e-5
RMS_EPS = 1e-5
DEEPNORM_ALPHA = (2 * DEPTH) ** 0.25
DEEPNORM_BETA = (8 * DEPTH) ** -0.25

kernel_name = "hybrid_diffattn_natten_moe_deepnorm"


def layer_norm(x, g, b):
    xf = x.astype(jnp.float32)
    mu = jnp.mean(xf, axis=-1, keepdims=True)
    var = jnp.mean(jnp.square(xf - mu), axis=-1, keepdims=True)
    return ((xf - mu) * lax.rsqrt(var + LN_EPS) * g + b).astype(x.dtype)


def rope_tables(seq, dim):
    pos = jnp.arange(seq, dtype=jnp.float32)
    inv = ROPE_THETA ** (-jnp.arange(0, dim, 2, dtype=jnp.float32) / dim)
    ang = pos[:, None] * inv[None, :]
    ang = jnp.concatenate([ang, ang], axis=-1)
    return jnp.cos(ang), jnp.sin(ang)


def apply_rope(x, cos, sin):
    c = cos[None, :, None, None, :]
    s = sin[None, :, None, None, :]
    x1, x2 = jnp.split(x, 2, axis=-1)
    rot = jnp.concatenate([-x2, x1], axis=-1)
    return (x.astype(jnp.float32) * c + rot.astype(jnp.float32) * s).astype(x.dtype)


def diff_attention(q, k, v, lam, lam_init, subln_g):
    B, S, H, _, d = q.shape
    nb = S // Q_BLOCK
    qb = (q * d ** -0.5).reshape(B, nb, Q_BLOCK, H, 2, d).transpose(1, 0, 2, 3, 4, 5)

    def block(q_blk):
        s = jnp.einsum('bqhcd,bkhcd->bhcqk', q_blk, k).astype(jnp.float32)
        p = jax.nn.softmax(s, axis=-1)
        w = p[:, :, 0] - lam * p[:, :, 1]
        return jnp.einsum('bhqk,bkhe->bqhe', w.astype(v.dtype), v)

    o = lax.map(block, qb)
    o = o.transpose(1, 0, 2, 3, 4).reshape(B, S, H, 2 * d).astype(jnp.float32)
    o = o * lax.rsqrt(jnp.mean(jnp.square(o), axis=-1, keepdims=True) + RMS_EPS) * subln_g
    return (o * (1.0 - lam_init)).reshape(B, S, H * 2 * d).astype(q.dtype)


def neighbourhood_attention(q, k, v, rpb):
    B, S, H, hd = q.shape
    rows = S // GRID_W
    kh = min(NA_KH_MAX, rows)
    q = (q * hd ** -0.5).reshape(B, rows, GRID_W, H, hd)
    k = k.reshape(B, rows, GRID_W, H, hd)
    v = v.reshape(B, rows, GRID_W, H, hd)
    cols = jnp.arange(GRID_W)
    col_start = jnp.clip(cols - NA_KW // 2, 0, GRID_W - NA_KW)
    col_idx = col_start[:, None] + jnp.arange(NA_KW)[None, :]
    col_off = col_idx - cols[:, None] + (NA_KW - 1)

    def row(r):
        rs = jnp.clip(r - kh // 2, 0, rows - kh)
        q_r = lax.dynamic_index_in_dim(q, r, axis=1, keepdims=False)
        k_rows = lax.dynamic_slice_in_dim(k, rs, kh, axis=1)
        v_rows = lax.dynamic_slice_in_dim(v, rs, kh, axis=1)
        k_win = k_rows[:, :, col_idx]
        v_win = v_rows[:, :, col_idx]
        row_off = rs + jnp.arange(kh) - r + (NA_KH_MAX - 1)
        bias = rpb[:, row_off[:, None, None], col_off[None, :, :]]
        s = jnp.einsum('bchd,bicjhd->bhcij', q_r, k_win).astype(jnp.float32)
        s = s + bias.transpose(0, 2, 1, 3)[None].astype(jnp.float32)
        p = jax.nn.softmax(s.reshape(B, H, GRID_W, kh * NA_KW), axis=-1).reshape(s.shape)
        return jnp.einsum('bhcij,bicjhd->bchd', p.astype(v.dtype), v_win)

    o = lax.map(row, jnp.arange(rows))
    return o.transpose(1, 0, 2, 3, 4).reshape(B, S, H * hd)


def hybrid_mixer(x, cos, sin, lam_init, w_in, b_in, lambda_q1, lambda_k1, lambda_q2,
                 lambda_k2, subln_g, rpb, w_branch_da, w_branch_na, w_out):
    B, S, D = x.shape
    proj = jnp.einsum('bsd,de->bse', x, w_in) + b_in
    q_da, k_da, v_da, q_na, k_na, v_na, gate_pre = jnp.split(proj, IN_SPLITS, axis=-1)
    q_da = apply_rope(q_da.reshape(B, S, DA_HEADS, 2, DA_HEAD_DIM), cos, sin)
    k_da = apply_rope(k_da.reshape(B, S, DA_HEADS, 2, DA_HEAD_DIM), cos, sin)
    v_da = v_da.reshape(B, S, DA_HEADS, DA_V_DIM)
    f32 = jnp.float32
    lam = (jnp.exp(jnp.sum(lambda_q1.astype(f32) * lambda_k1.astype(f32)))
           - jnp.exp(jnp.sum(lambda_q2.astype(f32) * lambda_k2.astype(f32))) + lam_init)
    a = diff_attention(q_da, k_da, v_da, lam, lam_init, subln_g)
    nb = neighbourhood_attention(q_na.reshape(B, S, NA_HEADS, NA_HEAD_DIM),
                                 k_na.reshape(B, S, NA_HEADS, NA_HEAD_DIM),
                                 v_na.reshape(B, S, NA_HEADS, NA_HEAD_DIM), rpb)
    ya = jnp.einsum('bse,ed->bsd', a, w_branch_da)
    yb = jnp.einsum('bse,ed->bsd', nb, w_branch_na)
    g = jax.nn.sigmoid(gate_pre.astype(f32)).reshape(B, S, N_BRANCHES, D)
    merged = (g[:, :, 0] * ya + g[:, :, 1] * yb).astype(x.dtype)
    return jnp.einsum('bsd,de->bse', merged, w_out)


def moe(x2, w_router, b_router, w_mlp1, b_mlp1, w_mlp2, b_mlp2):
    T, D = x2.shape
    TK = T * TOP_K
    logits = (x2 @ w_router + b_router).astype(jnp.float32)
    top_v, top_i = lax.top_k(logits, TOP_K)
    gates = jax.nn.softmax(top_v, axis=-1)
    flat_e = top_i.reshape(-1)
    flat_tok = jnp.arange(TK, dtype=jnp.int32) // TOP_K
    order = jnp.argsort(flat_e, stable=True)
    sorted_e = flat_e[order]
    counts = jnp.bincount(flat_e, length=N_EXPERTS)
    padded = ((counts + MOE_BLOCK - 1) // MOE_BLOCK) * MOE_BLOCK
    padded_end = jnp.cumsum(padded)
    padded_start = padded_end - padded
    group_start = jnp.cumsum(counts) - counts
    rank = jnp.arange(TK, dtype=jnp.int32) - group_start[sorted_e]
    dest = (padded_start[sorted_e] + rank).astype(jnp.int32)
    n_blocks = -(-TK // MOE_BLOCK) + N_EXPERTS
    P = n_blocks * MOE_BLOCK
    buf_tok = jnp.full((P,), T, dtype=jnp.int32).at[dest].set(flat_tok[order])
    x_pad = jnp.concatenate([x2, jnp.zeros((1, D), x2.dtype)], axis=0)
    xs = jnp.take(x_pad, buf_tok, axis=0).reshape(n_blocks, MOE_BLOCK, D)
    block_expert = jnp.clip(jnp.searchsorted(padded_end, jnp.arange(n_blocks) * MOE_BLOCK,
                                             side='right'), 0, N_EXPERTS - 1)

    def expert_block(args):
        xb, e = args
        h = xb @ w_mlp1[e] + b_mlp1[e]
        x_glu = jnp.minimum(h[:, ::2], SWIGLU_LIMIT)
        x_lin = jnp.clip(h[:, 1::2], -SWIGLU_LIMIT, SWIGLU_LIMIT)
        act = x_glu * jax.nn.sigmoid(SWIGLU_ALPHA * x_glu) * (x_lin + 1.0)
        return act @ w_mlp2[e] + b_mlp2[e]

    ys = lax.map(expert_block, (xs, block_expert)).reshape(P, D)
    dest_orig = jnp.zeros((TK,), jnp.int32).at[order].set(dest)
    y_slots = jnp.take(ys, dest_orig, axis=0).reshape(T, TOP_K, D)
    return jnp.sum(y_slots * gates[..., None].astype(ys.dtype), axis=1)


def setup_inputs(seed: int = 0) -> dict:
    key = jax.random.key(seed)
    ks = jax.random.split(key, 24)
    L = DEPTH
    f32 = jnp.float32

    def nrm(k, shape, s):
        return jax.random.normal(k, shape, f32) * s

    col_scale = jnp.concatenate([
        jnp.ones((2 * DA_WIDTH,), f32), jnp.full((DA_WIDTH,), DEEPNORM_BETA, f32),
        jnp.ones((2 * NA_WIDTH,), f32), jnp.full((NA_WIDTH,), DEEPNORM_BETA, f32),
        jnp.ones((N_BRANCHES * D_MODEL,), f32)])
    return {
        "x": nrm(ks[0], (BATCH, SEQ, D_MODEL), 1.0),
        "w_in": nrm(ks[1], (L, D_MODEL, IN_COLS), D_MODEL ** -0.5) * col_scale,
        "b_in": nrm(ks[2], (L, IN_COLS), 0.02),
        "lambda_q1": nrm(ks[3], (L, DA_HEAD_DIM), 0.1),
        "lambda_k1": nrm(ks[4], (L, DA_HEAD_DIM), 0.1),
        "lambda_q2": nrm(ks[5], (L, DA_HEAD_DIM), 0.1),
        "lambda_k2": nrm(ks[6], (L, DA_HEAD_DIM), 0.1),
        "subln_g": 1.0 + nrm(ks[7], (L, DA_V_DIM), 0.02),
        "rpb": nrm(ks[8], (L, NA_HEADS, 2 * NA_KH_MAX - 1, 2 * NA_KW - 1), 0.02),
        "w_branch_da": nrm(ks[9], (L, DA_WIDTH, D_MODEL), DA_WIDTH ** -0.5),
        "w_branch_na": nrm(ks[10], (L, NA_WIDTH, D_MODEL), NA_WIDTH ** -0.5),
        "w_out": nrm(ks[11], (L, D_MODEL, D_MODEL), D_MODEL ** -0.5) * DEEPNORM_BETA,
        "ln1_g": 1.0 + nrm(ks[12], (L, D_MODEL), 0.02),
        "ln1_b": nrm(ks[13], (L, D_MODEL), 0.02),
        "w_router": nrm(ks[14], (L, D_MODEL, N_EXPERTS), D_MODEL ** -0.5),
        "b_router": nrm(ks[15], (L, N_EXPERTS), 0.01),
        "w_mlp1": nrm(ks[16], (L, N_EXPERTS, D_MODEL, 2 * D_EXPERT), D_MODEL ** -0.5),
        "b_mlp1": nrm(ks[17], (L, N_EXPERTS, 2 * D_EXPERT), 0.02),
        "w_mlp2": nrm(ks[18], (L, N_EXPERTS, D_EXPERT, D_MODEL), D_EXPERT ** -0.5) * DEEPNORM_BETA,
        "b_mlp2": nrm(ks[19], (L, N_EXPERTS, D_MODEL), 0.02),
        "ln2_g": 1.0 + nrm(ks[20], (L, D_MODEL), 0.02),
        "ln2_b": nrm(ks[21], (L, D_MODEL), 0.02),
    }


def reference(x, w_in, b_in, lambda_q1, lambda_k1, lambda_q2, lambda_k2, subln_g, rpb,
              w_branch_da, w_branch_na, w_out, ln1_g, ln1_b, w_router, b_router,
              w_mlp1, b_mlp1, w_mlp2, b_mlp2, ln2_g, ln2_b):
    B, S, D = x.shape
    cos, sin = rope_tables(S, DA_HEAD_DIM)
    for l in range(DEPTH):
        lam_init = 0.8 - 0.6 * math.exp(-0.3 * l)
        mix = hybrid_mixer(x, cos, sin, lam_init, w_in[l], b_in[l], lambda_q1[l], lambda_k1[l],
                           lambda_q2[l], lambda_k2[l], subln_g[l], rpb[l],
                           w_branch_da[l], w_branch_na[l], w_out[l])
        x = layer_norm(DEEPNORM_ALPHA * x + mix, ln1_g[l], ln1_b[l])
        ffn = moe(x.reshape(B * S, D), w_router[l], b_router[l], w_mlp1[l], b_mlp1[l],
                  w_mlp2[l], b_mlp2[l]).reshape(B, S, D)
        x = layer_norm(DEEPNORM_ALPHA * x + ffn, ln2_g[l], ln2_b[l])
    return x
```

```cpp
#include <hip/hip_runtime.h>
#include <hip/hip_bf16.h>
#include <cstdio>
#include <cstdint>

#ifndef MK_SPLIT
#define MK_SPLIT 0
#endif

#define LAS __attribute__((address_space(3)))
#define GAS __attribute__((address_space(1)))
typedef unsigned short bf16_t;
typedef short bf16x8 __attribute__((ext_vector_type(8)));
typedef short s16x4 __attribute__((ext_vector_type(4)));
typedef float f32x2 __attribute__((ext_vector_type(2)));
typedef float f32x4 __attribute__((ext_vector_type(4)));
typedef float f32x16 __attribute__((ext_vector_type(16)));
typedef unsigned u32x2 __attribute__((ext_vector_type(2)));
typedef unsigned u32x4 __attribute__((ext_vector_type(4)));
typedef __bf16 bf16x2_t __attribute__((ext_vector_type(2)));
typedef int v4i_t __attribute__((ext_vector_type(4)));
typedef int v8i_t __attribute__((ext_vector_type(8)));

constexpr int DM = 1024, NBATCH = 4, SEQ = 8192, T = NBATCH * SEQ, INC = 5120;
constexpr int NE = 32, TOPK = 4, TK = T * TOPK, MAXTILES = TK / 256 + NE, PROWS = MAXTILES * 256, LCAP = T;
constexpr float LN_EPS = 1e-5f, RMS_EPS = 1e-5f;
constexpr float ALPHA = 1.189207115002721f;
constexpr float LAM_INIT = 0.2f;
constexpr float QSCALE = 0.125f * 1.4426950408889634f;
constexpr int NWAVES = 8, NTHR = 512;
constexpr float YSCALE = 16.f;
constexpr float XINSCALE = 16.f; constexpr int XIN_E8 = 127 - 4;
constexpr float WSCALE = 64.f, XSCALE = 8.f, HSCALE = 4.f; constexpr int WS_E8 = 127 - 6, XS_E8 = 127 - 3, HS_E8 = 127 - 2;

constexpr size_t MiB = 1u << 20;
constexpr size_t WS_CTL = 0, CTL_ZERO_BYTES = 1 * MiB;
constexpr size_t WS_CS = 1 * MiB;
constexpr size_t WS_BINP = 3 * MiB;
constexpr size_t WS_B1P = 3 * MiB + 65536;
constexpr size_t WS_TOPI = 4 * MiB, WS_TOPW = 4 * MiB + 524288, WS_RANK = 5 * MiB;
constexpr size_t WS_LIST = 6 * MiB;
constexpr size_t WS_WIN = 16 * MiB, WS_WDA = 26 * MiB, WS_WNA = 27 * MiB, WS_WOUT = 28 * MiB;
constexpr size_t WS_W1 = 32 * MiB, WS_W2 = 160 * MiB;
constexpr size_t WS_XB = 224 * MiB;
constexpr size_t WS_QKV = 288 * MiB;
constexpr size_t WS_G = 480 * MiB;
constexpr size_t WS_Y1 = 288 * MiB;
constexpr size_t WS_X1B = 544 * MiB;
constexpr size_t WS_H = 224 * MiB;
constexpr size_t WS_ADA = 608 * MiB, WS_ANA = 640 * MiB;
constexpr size_t WS_MERGED = 672 * MiB;
constexpr size_t WS_Y = 608 * MiB;
constexpr size_t WS_X1 = 880 * MiB;
constexpr size_t WS_END = 1008 * MiB;
static_assert(WS_H + (size_t)PROWS * 1024 * 2 <= WS_X1B && WS_Y + (size_t)PROWS * 1024 * 2 <= WS_X1, "ws map");
constexpr int CW_TMO = 0, CW_GCOUNT = 64, CW_KMAX = 128, CW_BAR = 4096;

constexpr int RING_BYTES = 131072;
constexpr int LDS_BYTES = 147456;
constexpr int MISC_OFF = LDS_BYTES - 1024;
constexpr int MW_BAR = 0, MW_LAM = 8, MW_TB = 16, MW_CNT = 96;

#define LDS_WAIT() asm volatile("s_waitcnt lgkmcnt(0)" ::: "memory")
#define VM_WAIT() asm volatile("s_waitcnt vmcnt(0)" ::: "memory")
#define RLX_AGENT __ATOMIC_RELAXED, __HIP_MEMORY_SCOPE_AGENT

__device__ __forceinline__ unsigned pk2(float lo, float hi) { f32x2 v = {lo, hi}; bf16x2_t b = __builtin_convertvector(v, bf16x2_t); return __builtin_bit_cast(unsigned, b); }
__device__ __forceinline__ unsigned pk4_fp8(float a, float b, float c, float d) { int w = 0; w = __builtin_amdgcn_cvt_pk_fp8_f32(a, b, w, false); w = __builtin_amdgcn_cvt_pk_fp8_f32(c, d, w, true); return (unsigned)w; }
__device__ __forceinline__ float bflo(unsigned w) { return __uint_as_float(w << 16); }
__device__ __forceinline__ float bfhi(unsigned w) { return __uint_as_float(w & 0xffff0000u); }
__device__ __forceinline__ float wave_sum(float v) {
#pragma unroll
    for (int o = 1; o < 64; o <<= 1) v += __shfl_xor(v, o);
    return v;
}
__device__ __forceinline__ float wave_max(float v) {
#pragma unroll
    for (int o = 1; o < 64; o <<= 1) v = fmaxf(v, __shfl_xor(v, o));
    return v;
}
__device__ __forceinline__ float sigmoidf_(float x) { return __builtin_amdgcn_rcpf(1.f + __builtin_amdgcn_exp2f(-1.4426950408889634f * x)); }

namespace pg8 {
constexpr int BM = 256, BK = 64, HALF = 128, HTB = HALF * BK * 2, STAGE_BYTES = 8 * HTB, NXCD = 8, WGM = 8;
__host__ __device__ __forceinline__ int lds_byte(int r, int c) { const int st = (r >> 4) * 2 + (c >> 5), rr = r & 15, cc = c & 31, ob = rr * 64 + cc * 2; return st * 1024 + (ob ^ (((ob >> 9) & 1) << 5)); }
__host__ __device__ __forceinline__ void stage_rc(int b, int& R, int& C) { const int st = b / 1024, sb = b % 1024, swz = sb ^ (((sb >> 9) & 1) << 5); R = (st >> 1) * 16 + swz / 64; C = (st & 1) * 32 + (swz % 64) / 2; }
__host__ __device__ __forceinline__ int perm32(int rho) { const int n = rho >> 4, i = rho & 15; return 8 * (i >> 2) + 4 * n + (i & 3); }

struct Unit { int pm, pn, e, nv, lbase, par; };

struct DenseOrder {
    static constexpr bool LIST_LDS = false;
    int nM, nN, nwg, G, c; const char* A; const char* Bt; size_t tstep;
    __device__ void init(int M, int N, int K, int G_, int c_, const void* A_, const void* Bt_) { nM = M / BM; nN = N / BM; nwg = nM * nN; G = G_; c = c_; A = (const char*)A_; Bt = (const char*)Bt_; tstep = (size_t)BM * K * 2; }
    __device__ __forceinline__ bool next(int i, Unit& u) const {
        const long L = (long)i * G + c; if (L >= nwg) return false;
        int wgid = (int)L; { const int q = nwg / NXCD, r = nwg % NXCD, xcd = wgid % NXCD, off = wgid / NXCD; wgid = (xcd < r ? xcd * (q + 1) : r * (q + 1) + (xcd - r) * q) + off; }
        const int nig = WGM * nN, gid = wgid / nig, fm = gid * WGM, gsz = (nM - fm) < WGM ? (nM - fm) : WGM;
        u.pm = fm + ((wgid % nig) % gsz); u.pn = (wgid % nig) / gsz; u.e = 0; u.nv = 256; u.lbase = 0; return true;
    }
    __device__ __forceinline__ const char* a_ptr(const Unit& u) const { return A + (size_t)u.pm * tstep; }
    __device__ __forceinline__ const char* b_ptr(const Unit& u) const { return Bt + (size_t)u.pn * tstep; }
    __device__ __forceinline__ void a_offs(const Unit&, const int (&)[2], const int (&)[2], unsigned (&)[2][2]) const {}
};
struct DenseOrderOff : DenseOrder {
    int rowb;
    __device__ __forceinline__ const char* a_ptr(const Unit&) const { return A; }
    __device__ __forceinline__ void a_offs(const Unit& u, const int (&Rr)[2], const int (&Cc)[2], unsigned (&vo)[2][2]) const {
#pragma unroll
        for (int h = 0; h < 2; ++h)
#pragma unroll
            for (int i = 0; i < 2; ++i) vo[h][i] = (unsigned)(u.pm * BM + h * HALF + Rr[i]) * (unsigned)rowb + (unsigned)Cc[i] * 2u;
    }
};
template <bool GATHER> struct GroupedOrder {
    const LAS int* tb; const LAS int* cnt; int npn, G, c, K; const char* A; const char* Bt; size_t tstepA, tstepB, estride; const int* list;
    mutable int e0 = 0;
    __device__ __forceinline__ bool next(int i, Unit& u) const {
        const int L = i * G + c; const int total = tb[NE] * npn; if (L >= total) return false;
        int e = e0; while (e < NE - 1 && tb[e + 1] * npn <= L) ++e;
        e = __builtin_amdgcn_readfirstlane(e); e0 = e;
        const int t0 = tb[e], nte = tb[e + 1] - t0, rem = L - t0 * npn, pn = rem / nte, it = rem - pn * nte;
        u.pm = __builtin_amdgcn_readfirstlane(t0 + it); u.pn = __builtin_amdgcn_readfirstlane(pn); u.e = e;
        int nv = cnt[e] - it * 256; nv = nv > 256 ? 256 : nv; u.nv = __builtin_amdgcn_readfirstlane(nv); u.lbase = __builtin_amdgcn_readfirstlane(e * LCAP + it * 256); return true;
    }
    static constexpr bool LIST_LDS = GATHER;
    static constexpr int LIST_OFF = STAGE_BYTES + 4096;
    __device__ __forceinline__ void list_dma(LAS unsigned char* l, const Unit& u, int par, int wid) const {
        if (wid == 3) { int lane; asm volatile("v_mbcnt_lo_u32_b32 %0, -1, 0\n\tv_mbcnt_hi_u32_b32 %0, -1, %0" : "=v"(lane));
            __builtin_amdgcn_global_load_lds((const unsigned*)(list + u.lbase + lane * 4), (LAS unsigned*)(l + LIST_OFF + par * 1024), 16, 0, 0); }
    }
    __device__ __forceinline__ void a_offs_lds(const LAS unsigned char* l, const Unit& u, int par, const int (&Rr)[2], const int (&Cc)[2], unsigned (&vo)[2][2]) const {
        const LAS int* ll = (const LAS int*)(l + LIST_OFF + par * 1024);
#pragma unroll
        for (int h = 0; h < 2; ++h)
#pragma unroll
            for (int i = 0; i < 2; ++i) { const int row = h * HALF + Rr[i]; const int v = ll[row]; const int tok = row < u.nv ? (v >> 2) : 0;
                vo[h][i] = (unsigned)tok * (unsigned)(K * 2) + (unsigned)Cc[i] * 2u; }
    }
    __device__ __forceinline__ const char* a_ptr(const Unit& u) const { return A; }
    __device__ __forceinline__ const char* b_ptr(const Unit& u) const { return Bt + (size_t)u.e * estride + (size_t)u.pn * tstepB; }
    __device__ __forceinline__ void a_offs(const Unit& u, const int (&Rr)[2], const int (&Cc)[2], unsigned (&vo)[2][2]) const {
#pragma unroll
        for (int h = 0; h < 2; ++h)
#pragma unroll
            for (int i = 0; i < 2; ++i) { const int row = h * HALF + Rr[i]; int tok = u.pm * BM + row; if constexpr (GATHER) { tok = 0; if (row < u.nv) tok = list[u.lbase + row] >> 2; }
                vo[h][i] = (unsigned)tok * (unsigned)(K * 2) + (unsigned)Cc[i] * 2u; }
    }
};

template <class Epi, class Sched, bool GATHER, bool FP8 = false, int sw = 127, int sx = 127>
__device__ __forceinline__ void gemm_phase(LAS unsigned char* lds, const int K, const Sched& S, const Epi& E) {
    const int tid = threadIdx.x, wid = __builtin_amdgcn_readfirstlane(tid >> 6), lane = tid & 63, wr = wid >> 2, wc = wid & 3, fr = lane & 15, fq = lane >> 4;
    const int nt = K / BK;
    unsigned voffB[2], voA[2][2], voN[2][2]; int Rr[2], Cc[2];
    const unsigned hstepu = (unsigned)HALF * (unsigned)K * 2u;
#pragma unroll
    for (int i = 0; i < 2; ++i) { int R, C; stage_rc(tid * 16 + i * 8192, R, C); const int Rb = Epi::PERM ? ((R & ~31) + perm32(R & 31)) : R;
        voffB[i] = (unsigned)(Rb * K + C) * 2u; Rr[i] = R; Cc[i] = C;
        voA[0][i] = (unsigned)(R * K + C) * 2u; voA[1][i] = voA[0][i] + hstepu; voN[0][i] = voA[0][i]; voN[1][i] = voA[1][i]; }
    const size_t kstep = (size_t)(BK * 2);
    const size_t hstep = (size_t)HALF * K * 2;
    const unsigned ldsw = (unsigned)wid * 1024u;
    const int aoff = lds_byte(wr * 64 + fr, fq * 8), boff = lds_byte(wc * 32 + fr, fq * 8);
#define PG8_SA(b, h) (((b) * 2 + (h)) * HTB)
#define PG8_SB(b, h) ((4 + (b) * 2 + (h)) * HTB)
#define PG8_STAGEB(bufoff, gbase) do { _Pragma("unroll") for (int _i = 0; _i < 2; ++_i) \
        __builtin_amdgcn_global_load_lds((const unsigned*)((const char*)(gbase) + voffB[_i]), (LAS unsigned*)(lds + (bufoff) + ldsw + _i * 8192), 16, 0, 0); } while (0)
#define PG8_STAGEA(bufoff, gbase, h) do { _Pragma("unroll") for (int _i = 0; _i < 2; ++_i) \
        __builtin_amdgcn_global_load_lds((const unsigned*)((const char*)(gbase) + voA[h][_i]), (LAS unsigned*)(lds + (bufoff) + ldsw + _i * 8192), 16, 0, 0); } while (0)
#define PG8_LDA(dst, b, h) do { _Pragma("unroll") for (int m = 0; m < 4; ++m) _Pragma("unroll") for (int k = 0; k < 2; ++k) dst[m][k] = *(const LAS bf16x8*)(lds + PG8_SA(b, h) + aoff + m * 2048 + k * 1024); } while (0)
#define PG8_LDB(dst, b, h) do { _Pragma("unroll") for (int n = 0; n < 2; ++n) _Pragma("unroll") for (int k = 0; k < 2; ++k) dst[n][k] = *(const LAS bf16x8*)(lds + PG8_SB(b, h) + boff + n * 2048 + k * 1024); } while (0)
#define PG8_V8(x) __builtin_shufflevector(__builtin_bit_cast(v4i_t, x[0]), __builtin_bit_cast(v4i_t, x[1]), 0, 1, 2, 3, 4, 5, 6, 7)
#define PG8_MMA(ai, bj, At, Bt) do { __builtin_amdgcn_s_setprio(1); if constexpr (FP8) { _Pragma("unroll") for (int m = 0; m < 4; ++m) _Pragma("unroll") for (int n = 0; n < 2; ++n) \
        acc[ai][bj][m][n] = __builtin_amdgcn_mfma_scale_f32_16x16x128_f8f6f4(PG8_V8(Bt[n]), PG8_V8(At[m]), acc[ai][bj][m][n], 0, 0, 0, sw, 0, sx); } else { \
        _Pragma("unroll") for (int m = 0; m < 4; ++m) _Pragma("unroll") for (int n = 0; n < 2; ++n) _Pragma("unroll") for (int k = 0; k < 2; ++k) \
        acc[ai][bj][m][n] = __builtin_amdgcn_mfma_f32_16x16x32_bf16(Bt[n][k], At[m][k], acc[ai][bj][m][n], 0, 0, 0); } __builtin_amdgcn_s_setprio(0); } while (0)
#define PG8_WAIT_V(n) asm volatile("s_waitcnt vmcnt(" #n ")" ::: "memory")
#define PG8_WAIT_L(n) asm volatile("s_waitcnt lgkmcnt(" #n ")" ::: "memory")
#define PG8_BAR __builtin_amdgcn_s_barrier()
#define PG8_SCHED __builtin_amdgcn_sched_barrier(0)
#define PG8_PIN4(v) asm volatile("" : "+v"(v[0][0]), "+v"(v[0][1]), "+v"(v[1][0]), "+v"(v[1][1]))
    Unit cur, nxt; int ui = 0;
    if (!S.next(0, cur)) return;
    cur.par = 0;
    f32x4 acc[2][2][4][2];
#pragma unroll
    for (int a = 0; a < 2; ++a)
#pragma unroll
        for (int b = 0; b < 2; ++b)
#pragma unroll
            for (int m = 0; m < 4; ++m)
#pragma unroll
                for (int n = 0; n < 2; ++n) acc[a][b][m][n] = (f32x4){0.f, 0.f, 0.f, 0.f};
    bf16x8 At[4][2], B0[2][2], B1[2][2];
    const char* cA = S.a_ptr(cur); const char* cB = S.b_ptr(cur);
    if constexpr (GATHER) { S.a_offs(cur, Rr, Cc, voA); PG8_WAIT_V(0); PG8_PIN4(voA); }
    Unit nn; bool has_nn = false;
    if constexpr (Sched::LIST_LDS) { has_nn = S.next(1, nn); if (has_nn) S.list_dma(lds, nn, 1, wid); }
    PG8_STAGEB(PG8_SB(0, 0), cB); PG8_STAGEB(PG8_SB(0, 1), cB + hstep); PG8_STAGEA(PG8_SA(0, 0), cA, 0); PG8_STAGEA(PG8_SA(0, 1), cA, 1);
    if (wr == 1) PG8_BAR;
    PG8_WAIT_V(2); PG8_BAR;
    PG8_STAGEB(PG8_SB(1, 0), cB + kstep); PG8_STAGEA(PG8_SA(1, 0), cA + kstep, 0); PG8_STAGEB(PG8_SB(1, 1), cB + hstep + kstep);
    PG8_WAIT_V(6); PG8_BAR;
    for (;;) {
        bool has_next;
        if constexpr (Sched::LIST_LDS) { has_next = has_nn; nxt = nn; } else has_next = S.next(ui + 1, nxt);
        nxt.par = (ui + 1) & 1;
        const char* nA = has_next ? S.a_ptr(nxt) : cA; const char* nB = has_next ? S.b_ptr(nxt) : cB;
        if constexpr (GATHER) {
            if (has_next) { if constexpr (Sched::LIST_LDS) S.a_offs_lds(lds, nxt, (ui + 1) & 1, Rr, Cc, voN); else S.a_offs(nxt, Rr, Cc, voN); } else {
#pragma unroll
                for (int h = 0; h < 2; ++h)
#pragma unroll
                    for (int i = 0; i < 2; ++i) voN[h][i] = voA[h][i]; }
            if constexpr (Sched::LIST_LDS) { has_nn = has_next && S.next(ui + 2, nn); if (has_nn) S.list_dma(lds, nn, ui & 1, wid); PG8_WAIT_L(0); }
            else PG8_WAIT_V(0);
            PG8_PIN4(voN);
        }
        if constexpr (Epi::HAS_PRE) { E.pre(lds, cur, wid); PG8_SCHED; }
#pragma unroll 1
        for (int t = 0; t < nt; t += 2) {
            const bool last = (t == nt - 2);
            const char* a1 = cA + (size_t)(t + 1) * kstep;
            const char* a2 = last ? nA : cA + (size_t)(t + 2) * kstep; const char* b2 = last ? nB : cB + (size_t)(t + 2) * kstep;
            const char* a3 = a2 + kstep; const char* b3 = b2 + kstep;
            PG8_LDB(B0, 0, 0); PG8_LDB(B1, 0, 1); PG8_SCHED; PG8_LDA(At, 0, 0); PG8_STAGEA(PG8_SA(1, 1), a1, 1);
            if constexpr (GATHER) { if (last) {
#pragma unroll
                for (int h = 0; h < 2; ++h)
#pragma unroll
                    for (int i = 0; i < 2; ++i) voA[h][i] = voN[h][i]; } }
            PG8_WAIT_V(8); PG8_WAIT_L(0); PG8_BAR; PG8_MMA(0, 0, At, B0); PG8_MMA(0, 1, At, B1); PG8_BAR; PG8_SCHED;
            PG8_LDA(At, 0, 1); PG8_STAGEB(PG8_SB(0, 0), b2); PG8_STAGEB(PG8_SB(0, 1), b2 + hstep); PG8_STAGEA(PG8_SA(0, 0), a2, 0);
            PG8_WAIT_V(8); PG8_WAIT_L(0); PG8_BAR; PG8_MMA(1, 0, At, B0); PG8_MMA(1, 1, At, B1); PG8_BAR; PG8_SCHED;
            PG8_LDB(B0, 1, 0); PG8_LDB(B1, 1, 1); PG8_SCHED; PG8_LDA(At, 1, 0); PG8_STAGEA(PG8_SA(0, 1), a2, 1);
            PG8_WAIT_V(8); PG8_WAIT_L(0); PG8_BAR; PG8_MMA(0, 0, At, B0); PG8_MMA(0, 1, At, B1); PG8_BAR; PG8_SCHED;
            PG8_LDA(At, 1, 1); PG8_STAGEB(PG8_SB(1, 0), b3); PG8_STAGEB(PG8_SB(1, 1), b3 + hstep); PG8_STAGEA(PG8_SA(1, 0), a3, 0);
            PG8_WAIT_V(8); PG8_WAIT_L(0); PG8_BAR; PG8_MMA(1, 0, At, B0); PG8_MMA(1, 1, At, B1); PG8_BAR; PG8_SCHED;
            if constexpr (Epi::HAS_MID) { if (t + 2 == nt / 2) { E.mid(acc, cur, wr, wc, fr, fq); PG8_SCHED; } }
        }
        if (wr == 0) PG8_BAR;
        E(acc, cur, wr, wc, fr, fq);
        if (!has_next) break;
#pragma unroll
        for (int a = 0; a < 2; ++a)
#pragma unroll
            for (int b = 0; b < 2; ++b)
#pragma unroll
                for (int m = 0; m < 4; ++m)
#pragma unroll
                    for (int n = 0; n < 2; ++n) acc[a][b][m][n] = (f32x4){0.f, 0.f, 0.f, 0.f};
        cur = nxt; cA = nA; cB = nB; ++ui;
        if (wr == 1) PG8_BAR;
    }
    PG8_WAIT_V(0);
    PG8_BAR;
#undef PG8_SA
#undef PG8_SB
#undef PG8_STAGEA
#undef PG8_STAGEB
#undef PG8_LDA
#undef PG8_LDB
#undef PG8_MMA
#undef PG8_V8
#undef PG8_WAIT_V
#undef PG8_WAIT_L
#undef PG8_BAR
#undef PG8_SCHED
#undef PG8_PIN4
}

struct EpiInProj {
    static constexpr bool PERM = true, HAS_MID = false, HAS_PRE = true;
    bf16_t* QKV; bf16_t* G; const float* binp; const f32x2* cs; unsigned* kmax; LAS unsigned char* lds;
    __device__ __forceinline__ void pre(LAS unsigned char* l, const Unit& u, int wid) const {
        if (wid == 0) { int lane; asm volatile("v_mbcnt_lo_u32_b32 %0, -1, 0\n\tv_mbcnt_hi_u32_b32 %0, -1, %0" : "=v"(lane));
            __builtin_amdgcn_global_load_lds((const unsigned*)(binp + u.pn * BM + lane * 4), (LAS unsigned*)(l + STAGE_BYTES + u.par * 2048), 16, 0, 0); }
    }
    __device__ __forceinline__ void operator()(const f32x4 (&acc)[2][2][4][2], const Unit& u, int wr, int wc, int fr, int fq) const {
        const int colt = u.pn * BM, tt = colt >> 9;
        const int cw = wc * 32 + 8 * fq;
        f32x4 bv[2][2];
#pragma unroll
        for (int bj = 0; bj < 2; ++bj)
#pragma unroll
            for (int n = 0; n < 2; ++n) bv[bj][n] = *(const LAS f32x4*)((const LAS float*)(lds + STAGE_BYTES + u.par * 2048) + bj * HALF + cw + 4 * n);
        float kmx[2] = {0.f, 0.f};
#pragma unroll
        for (int ai = 0; ai < 2; ++ai)
#pragma unroll
            for (int m = 0; m < 4; ++m) {
                const int row = u.pm * BM + ai * HALF + wr * 64 + m * 16 + fr;
#pragma unroll
                for (int bj = 0; bj < 2; ++bj) {
                    f32x4 v0 = acc[ai][bj][m][0] + bv[bj][0], v1 = acc[ai][bj][m][1] + bv[bj][1];
                    const int col = colt + bj * HALF + cw;
                    u32x4 w;
                    if (tt < 2) {
                        const int pos = row & (SEQ - 1), dp = (col & 63) >> 1;
                        const f32x4 c01 = *(const f32x4*)(cs + (size_t)pos * 32 + dp), c23 = *(const f32x4*)(cs + (size_t)pos * 32 + dp + 2);
                        const float a0 = v0[0] * c01[0] - v0[1] * c01[1], b0 = v0[1] * c01[0] + v0[0] * c01[1];
                        const float a1 = v0[2] * c01[2] - v0[3] * c01[3], b1 = v0[3] * c01[2] + v0[2] * c01[3];
                        const float a2 = v1[0] * c23[0] - v1[1] * c23[1], b2 = v1[1] * c23[0] + v1[0] * c23[1];
                        const float a3 = v1[2] * c23[2] - v1[3] * c23[3], b3 = v1[3] * c23[2] + v1[2] * c23[3];
                        if (tt == 1) { float ss = (a0 * a0 + b0 * b0) + (a1 * a1 + b1 * b1) + (a2 * a2 + b2 * b2) + (a3 * a3 + b3 * b3);
                            ss += __shfl_xor(ss, 16); ss += __shfl_xor(ss, 32);
                            kmx[bj] = fmaxf(kmx[bj], ss); }
                        const float qs = tt == 0 ? QSCALE : 1.0f;
                        w.x = pk2(a0 * qs, b0 * qs); w.y = pk2(a1 * qs, b1 * qs); w.z = pk2(a2 * qs, b2 * qs); w.w = pk2(a3 * qs, b3 * qs);
                    } else if (tt < 6) {
                        if (tt == 4) { float ss = (v0[0] * v0[0] + v0[1] * v0[1]) + (v0[2] * v0[2] + v0[3] * v0[3]) + (v1[0] * v1[0] + v1[1] * v1[1]) + (v1[2] * v1[2] + v1[3] * v1[3]);
                            ss += __shfl_xor(ss, 16); ss += __shfl_xor(ss, 32); kmx[bj] = fmaxf(kmx[bj], ss); }
                        const float qs = tt == 3 ? QSCALE : 1.0f;
                        w.x = pk2(v0[0] * qs, v0[1] * qs); w.y = pk2(v0[2] * qs, v0[3] * qs); w.z = pk2(v1[0] * qs, v1[1] * qs); w.w = pk2(v1[2] * qs, v1[3] * qs);
                    } else {
                        w.x = pk2(sigmoidf_(v0[0]), sigmoidf_(v0[1])); w.y = pk2(sigmoidf_(v0[2]), sigmoidf_(v0[3]));
                        w.z = pk2(sigmoidf_(v1[0]), sigmoidf_(v1[1])); w.w = pk2(sigmoidf_(v1[2]), sigmoidf_(v1[3]));
                    }
                    if (tt < 6) *(u32x4*)(QKV + (size_t)tt * ((size_t)T * 512) + (size_t)row * 512 + (col - tt * 512)) = w;
                    else *(u32x4*)(G + (size_t)row * 2048 + (col - 3072)) = w;
                }
            }
        if (tt == 1 || tt == 4) {
#pragma unroll
            for (int bj = 0; bj < 2; ++bj) { float v = kmx[bj];
                v = fmaxf(v, __shfl_xor(v, 1)); v = fmaxf(v, __shfl_xor(v, 2)); v = fmaxf(v, __shfl_xor(v, 4)); v = fmaxf(v, __shfl_xor(v, 8));
                const int c32 = (colt - tt * 512 + bj * HALF + wc * 32) >> 5, b = (u.pm * BM) >> 13;
                if ((threadIdx.x & 63) == 0) atomicMax(kmax + (tt == 4 ? 64 : 0) + b * 16 + c32, __float_as_uint(v)); }
        }
    }
};
template <int MODE> struct EpiGate {
    static constexpr bool PERM = true, HAS_MID = false, HAS_PRE = false;
    bf16_t* M; const bf16_t* G; int goff;
    __device__ __forceinline__ void operator()(const f32x4 (&acc)[2][2][4][2], const Unit& u, int wr, int wc, int fr, int fq) const {
#pragma unroll
        for (int ai = 0; ai < 2; ++ai)
#pragma unroll
            for (int m = 0; m < 4; ++m) {
                const int row = u.pm * BM + ai * HALF + wr * 64 + m * 16 + fr;
#pragma unroll
                for (int bj = 0; bj < 2; ++bj) {
                    const int col = u.pn * BM + bj * HALF + wc * 32 + 8 * fq;
                    const u32x4 g = *(const u32x4*)(G + (size_t)row * 2048 + goff + col);
                    const f32x4 v0 = acc[ai][bj][m][0], v1 = acc[ai][bj][m][1];
                    float o[8] = {bflo(g.x) * v0[0], bfhi(g.x) * v0[1], bflo(g.y) * v0[2], bfhi(g.y) * v0[3], bflo(g.z) * v1[0], bfhi(g.z) * v1[1], bflo(g.w) * v1[2], bfhi(g.w) * v1[3]};
                    bf16_t* dst = M + (size_t)row * 1024 + col;
                    if (MODE == 1) { const u32x4 p = *(const u32x4*)dst; o[0] += bflo(p.x); o[1] += bfhi(p.x); o[2] += bflo(p.y); o[3] += bfhi(p.y); o[4] += bflo(p.z); o[5] += bfhi(p.z); o[6] += bflo(p.w); o[7] += bfhi(p.w); }
                    u32x4 w; w.x = pk2(o[0], o[1]); w.y = pk2(o[2], o[3]); w.z = pk2(o[4], o[5]); w.w = pk2(o[6], o[7]);
                    *(u32x4*)dst = w;
                }
            }
    }
};
struct EpiGate2 {
    static constexpr bool PERM = true, HAS_MID = true, HAS_PRE = false;
    bf16_t* M; const bf16_t* G;
    __device__ __forceinline__ void mid(f32x4 (&acc)[2][2][4][2], const Unit& u, int wr, int wc, int fr, int fq) const {
#pragma unroll
        for (int ai = 0; ai < 2; ++ai)
#pragma unroll
            for (int m = 0; m < 4; ++m) {
                const int row = u.pm * BM + ai * HALF + wr * 64 + m * 16 + fr;
#pragma unroll
                for (int bj = 0; bj < 2; ++bj) {
                    const int col = u.pn * BM + bj * HALF + wc * 32 + 8 * fq;
                    const u32x4 ga = *(const u32x4*)(G + (size_t)row * 2048 + col), gb = *(const u32x4*)(G + (size_t)row * 2048 + 1024 + col);
                    const float r0 = bflo(ga.x) * __builtin_amdgcn_rcpf(fmaxf(bflo(gb.x), 1e-30f)), r1 = bfhi(ga.x) * __builtin_amdgcn_rcpf(fmaxf(bfhi(gb.x), 1e-30f));
                    const float r2 = bflo(ga.y) * __builtin_amdgcn_rcpf(fmaxf(bflo(gb.y), 1e-30f)), r3 = bfhi(ga.y) * __builtin_amdgcn_rcpf(fmaxf(bfhi(gb.y), 1e-30f));
                    const float r4 = bflo(ga.z) * __builtin_amdgcn_rcpf(fmaxf(bflo(gb.z), 1e-30f)), r5 = bfhi(ga.z) * __builtin_amdgcn_rcpf(fmaxf(bfhi(gb.z), 1e-30f));
                    const float r6 = bflo(ga.w) * __builtin_amdgcn_rcpf(fmaxf(bflo(gb.w), 1e-30f)), r7 = bfhi(ga.w) * __builtin_amdgcn_rcpf(fmaxf(bfhi(gb.w), 1e-30f));
                    acc[ai][bj][m][0] = acc[ai][bj][m][0] * (f32x4){r0, r1, r2, r3}; acc[ai][bj][m][1] = acc[ai][bj][m][1] * (f32x4){r4, r5, r6, r7};
                }
            }
    }
    __device__ __forceinline__ void operator()(const f32x4 (&acc)[2][2][4][2], const Unit& u, int wr, int wc, int fr, int fq) const {
#pragma unroll
        for (int ai = 0; ai < 2; ++ai)
#pragma unroll
            for (int m = 0; m < 4; ++m) {
                const int row = u.pm * BM + ai * HALF + wr * 64 + m * 16 + fr;
#pragma unroll
                for (int bj = 0; bj < 2; ++bj) {
                    const int col = u.pn * BM + bj * HALF + wc * 32 + 8 * fq;
                    const u32x4 g = *(const u32x4*)(G + (size_t)row * 2048 + 1024 + col);
                    const f32x4 v0 = acc[ai][bj][m][0], v1 = acc[ai][bj][m][1];
                    u32x4 w; w.x = pk2(bflo(g.x) * v0[0], bfhi(g.x) * v0[1]); w.y = pk2(bflo(g.y) * v0[2], bfhi(g.y) * v0[3]); w.z = pk2(bflo(g.z) * v1[0], bfhi(g.z) * v1[1]); w.w = pk2(bflo(g.w) * v1[2], bfhi(g.w) * v1[3]);
                    *(u32x4*)(M + (size_t)row * 1024 + col) = w;
                }
            }
    }
};
struct EpiResF32 {
    static constexpr bool PERM = true, HAS_MID = false, HAS_PRE = false;
    bf16_t* Y;
    __device__ __forceinline__ void operator()(const f32x4 (&acc)[2][2][4][2], const Unit& u, int wr, int wc, int fr, int fq) const {
        const int cw = u.pn * BM + wc * 32 + 8 * fq;
#pragma unroll
        for (int ai = 0; ai < 2; ++ai)
#pragma unroll
            for (int m = 0; m < 4; ++m) {
                const int row = u.pm * BM + ai * HALF + wr * 64 + m * 16 + fr;
#pragma unroll
                for (int bj = 0; bj < 2; ++bj) { const f32x4 v0 = acc[ai][bj][m][0], v1 = acc[ai][bj][m][1];
                    u32x4 w; w.x = pk2(v0[0], v0[1]); w.y = pk2(v0[2], v0[3]); w.z = pk2(v1[0], v1[1]); w.w = pk2(v1[2], v1[3]);
                    *(u32x4*)(Y + (size_t)row * DM + cw + bj * HALF) = w; }
            }
    }
};
constexpr int EPI_PRE_OFF = STAGE_BYTES;
struct EpiSwiglu {
    static constexpr bool PERM = true, HAS_MID = false, HAS_PRE = true;
    unsigned char* H; const float* b1p; LAS unsigned char* lds;
    __device__ __forceinline__ void pre(LAS unsigned char* l, const Unit& u, int wid) const {
        if (wid == 0) { int lane; asm volatile("v_mbcnt_lo_u32_b32 %0, -1, 0\n\tv_mbcnt_hi_u32_b32 %0, -1, %0" : "=v"(lane));
            __builtin_amdgcn_global_load_lds((const unsigned*)(b1p + (size_t)u.e * 2048 + u.pn * BM + lane * 4), (LAS unsigned*)(l + EPI_PRE_OFF + u.par * 2048), 16, 0, 0); }
    }
    __device__ __forceinline__ void operator()(const f32x4 (&acc)[2][2][4][2], const Unit& u, int wr, int wc, int fr, int fq) const {
        const int cw = wc * 32 + 8 * fq; const LAS float* bb = (const LAS float*)(lds + EPI_PRE_OFF + u.par * 2048) + cw;
        const f32x4 bg0 = *(const LAS f32x4*)(bb), bg1 = *(const LAS f32x4*)(bb + 4), bl0 = *(const LAS f32x4*)(bb + HALF), bl1 = *(const LAS f32x4*)(bb + HALF + 4);
#pragma unroll
        for (int ai = 0; ai < 2; ++ai)
#pragma unroll
            for (int m = 0; m < 4; ++m) {
                const int row = u.pm * BM + ai * HALF + wr * 64 + m * 16 + fr;
                const f32x4 g0 = acc[ai][0][m][0] + bg0, g1 = acc[ai][0][m][1] + bg1, l0 = acc[ai][1][m][0] + bl0, l1 = acc[ai][1][m][1] + bl1;
                float o[8];
#pragma unroll
                for (int i = 0; i < 8; ++i) { const float g = fminf(i < 4 ? g0[i & 3] : g1[i & 3], 7.0f); const float l = __builtin_amdgcn_fmed3f(i < 4 ? l0[i & 3] : l1[i & 3], -7.0f, 7.0f);
                    const float r = __builtin_amdgcn_rcpf(1.f + __builtin_amdgcn_exp2f(g * (-1.702f * 1.4426950408889634f)));
                    o[i] = (g * r) * fmaf(l, HSCALE, HSCALE); }
                u32x2 w; w.x = pk4_fp8(o[0], o[1], o[2], o[3]); w.y = pk4_fp8(o[4], o[5], o[6], o[7]);
                *(u32x2*)(H + (size_t)row * 1024 + u.pn * HALF + cw) = w;
            }
    }
};
struct EpiDown {
    static constexpr bool PERM = true, HAS_MID = false, HAS_PRE = true;
    unsigned char* Y; const float* b2; const int* list; LAS unsigned char* lds;
    __device__ __forceinline__ void pre(LAS unsigned char* l, const Unit& u, int wid) const {
        if (wid < 2) { int lane; asm volatile("v_mbcnt_lo_u32_b32 %0, -1, 0\n\tv_mbcnt_hi_u32_b32 %0, -1, %0" : "=v"(lane));
            const unsigned* src = wid == 0 ? (const unsigned*)(b2 + (size_t)u.e * 1024 + u.pn * BM) : (const unsigned*)(list + u.lbase);
            __builtin_amdgcn_global_load_lds(src + lane * 4, (LAS unsigned*)(l + EPI_PRE_OFF + u.par * 2048 + wid * 1024), 16, 0, 0); }
    }
    __device__ __forceinline__ void operator()(const f32x4 (&acc)[2][2][4][2], const Unit& u, int wr, int wc, int fr, int fq) const {
        const int cw = u.pn * BM + wc * 32 + 8 * fq; const LAS float* bb = (const LAS float*)(lds + EPI_PRE_OFF + u.par * 2048) + wc * 32 + 8 * fq;
        const LAS int* ll = (const LAS int*)(lds + EPI_PRE_OFF + u.par * 2048 + 1024);
        int dst[2][4];
#pragma unroll
        for (int ai = 0; ai < 2; ++ai)
#pragma unroll
            for (int m = 0; m < 4; ++m) { const int lr = ai * HALF + wr * 64 + m * 16 + fr; const int v = ll[lr]; dst[ai][m] = lr < u.nv ? v : -1; }
#pragma unroll
        for (int bj = 0; bj < 2; ++bj) {
            const f32x4 bv0 = *(const LAS f32x4*)(bb + bj * HALF), bv1 = *(const LAS f32x4*)(bb + bj * HALF + 4);
#pragma unroll
            for (int ai = 0; ai < 2; ++ai)
#pragma unroll
                for (int m = 0; m < 4; ++m) {
                    const f32x4 v0 = acc[ai][bj][m][0] + bv0, v1 = acc[ai][bj][m][1] + bv1;
                    u32x2 w; w.x = pk4_fp8(v0[0] * YSCALE, v0[1] * YSCALE, v0[2] * YSCALE, v0[3] * YSCALE); w.y = pk4_fp8(v1[0] * YSCALE, v1[1] * YSCALE, v1[2] * YSCALE, v1[3] * YSCALE);
                    if (dst[ai][m] >= 0) *(u32x2*)(Y + (size_t)dst[ai][m] * 1024 + cw + bj * HALF) = w; }
        }
    }
};
}

__device__ __forceinline__ int lane_now() { int l; asm volatile("v_mbcnt_lo_u32_b32 %0, -1, 0\n\tv_mbcnt_hi_u32_b32 %0, -1, %0" : "=v"(l)); return l; }
namespace da {
using bf16 = __hip_bfloat16;
constexpr int NW = 8, QBLK = 32, KVBLK = 64, LDK = 512, UROWS = 128, OLD = 1024;
constexpr float SCALE = 0.125f, THR = 8.f;
constexpr size_t SHM_V = KVBLK * 128 * 2, SHM_K = KVBLK * 128 * 2, SHM_WS = 2 * SHM_V + 2 * SHM_K;
#define KSWZ(row, colB) ((row) * 256 + ((colB) ^ (((row) & 7) << 4)))
#define SBAR() __builtin_amdgcn_sched_barrier(0)
__device__ __forceinline__ int crow(int r, int hi) { return (r & 3) + 8 * (r >> 2) + 4 * hi; }
__device__ __forceinline__ unsigned cvtpk(float lo, float hi) { unsigned r; asm volatile("v_cvt_pk_bf16_f32 %0, %1, %2" : "=v"(r) : "v"(lo), "v"(hi)); return r; }
__device__ __forceinline__ void partialSM(f32x16& p0, f32x16& p1, float& m_reg, float& mn, float& alpha) {
    constexpr float C = SCALE * 1.4426950408889634f;
    float pmax = p0[0];
#pragma unroll
    for (int r = 1; r < 16; ++r) pmax = fmaxf(pmax, p0[r]);
#pragma unroll
    for (int r = 0; r < 16; ++r) pmax = fmaxf(pmax, p1[r]);
    { auto rr = __builtin_amdgcn_permlane32_swap(__float_as_uint(pmax), __float_as_uint(pmax), false, false); pmax = fmaxf(__uint_as_float(rr[0]), __uint_as_float(rr[1])); }
    if (__builtin_expect(__all(pmax - m_reg <= THR / SCALE), 1)) { mn = m_reg; alpha = 1.f; }
    else { mn = fmaxf(m_reg, pmax); alpha = __builtin_amdgcn_exp2f((m_reg - mn) * C); m_reg = mn; }
    const float mnC = -mn * C;
#pragma unroll
    for (int r = 0; r < 16; ++r) p0[r] = fmaf(p0[r], C, mnC);
#pragma unroll
    for (int r = 0; r < 16; ++r) p1[r] = fmaf(p1[r], C, mnC);
#pragma unroll
    for (int r = 0; r < 16; ++r) p0[r] = __builtin_amdgcn_exp2f(p0[r]);
}
__device__ __forceinline__ void finishSM(f32x16& p0, f32x16& p1, float alpha, float& l_reg, bf16x8& pa0, bf16x8& pa1, bf16x8& pa2, bf16x8& pa3) {
#pragma unroll
    for (int r = 0; r < 16; ++r) p1[r] = __builtin_amdgcn_exp2f(p1[r]);
    float ps = 0;
#pragma unroll
    for (int r = 0; r < 16; ++r) ps += p0[r];
#pragma unroll
    for (int r = 0; r < 16; ++r) ps += p1[r];
    { auto rr = __builtin_amdgcn_permlane32_swap(__float_as_uint(ps), __float_as_uint(ps), false, false); ps = __uint_as_float(rr[0]) + __uint_as_float(rr[1]); }
    l_reg = l_reg * alpha + ps;
#define PK4(P, BASE, OUT) do { u32x4 w = {pk2(P[BASE + 0], P[BASE + 1]), pk2(P[BASE + 2], P[BASE + 3]), pk2(P[BASE + 4], P[BASE + 5]), pk2(P[BASE + 6], P[BASE + 7])}; \
    OUT = *reinterpret_cast<bf16x8*>(&w); } while (0)
    PK4(p0, 0, pa0); PK4(p0, 8, pa1); PK4(p1, 0, pa2); PK4(p1, 8, pa3);
#undef PK4
}
__device__ __forceinline__ void qkt(f32x16& p0, f32x16& p1, const char* Ks, const bf16x8* qr, int r32, int hi) {
    p0 = f32x16{}; p1 = f32x16{};
#pragma unroll
    for (int d0 = 0; d0 < 4; ++d0) { const int cb = (d0 * 16 + hi * 8) * 2;
        const bf16x8 b0 = *reinterpret_cast<const bf16x8*>(Ks + KSWZ(r32, cb));
        const bf16x8 b1 = *reinterpret_cast<const bf16x8*>(Ks + KSWZ(32 + r32, cb));
        p0 = __builtin_amdgcn_mfma_f32_32x32x16_bf16(b0, qr[d0], p0, 0, 0, 0);
        p1 = __builtin_amdgcn_mfma_f32_32x32x16_bf16(b1, qr[d0], p1, 0, 0, 0); }
}
constexpr float THR_L2 = 11.541560327111707f;
__device__ __forceinline__ void qkt2(f32x16& p0, f32x16& p1, const char* Ks, const bf16x8* qr, const f32x16& negm, int r32, int hi) {
#pragma unroll
    for (int d0 = 0; d0 < 4; ++d0) { const int cb = (d0 * 16 + hi * 8) * 2;
        const bf16x8 b0 = *reinterpret_cast<const bf16x8*>(Ks + KSWZ(r32, cb));
        const bf16x8 b1 = *reinterpret_cast<const bf16x8*>(Ks + KSWZ(32 + r32, cb));
        if (d0 == 0) { p0 = __builtin_amdgcn_mfma_f32_32x32x16_bf16(b0, qr[0], negm, 0, 0, 0); p1 = __builtin_amdgcn_mfma_f32_32x32x16_bf16(b1, qr[0], negm, 0, 0, 0); }
        else { p0 = __builtin_amdgcn_mfma_f32_32x32x16_bf16(b0, qr[d0], p0, 0, 0, 0); p1 = __builtin_amdgcn_mfma_f32_32x32x16_bf16(b1, qr[d0], p1, 0, 0, 0); } }
}
template <bool FIRST>
__device__ __forceinline__ void psm2(f32x16& p0, f32x16& p1, float& m, f32x16& negm, float& alpha) {
    float a = fmaxf(fmaxf(p0[0], p0[1]), p1[0]), b = fmaxf(fmaxf(p0[2], p0[3]), p1[1]); a = fmaxf(fmaxf(a, p1[2]), p1[3]);
#pragma unroll
    for (int r = 4; r < 16; r += 4) { a = fmaxf(fmaxf(a, p0[r]), p0[r + 1]); b = fmaxf(fmaxf(b, p0[r + 2]), p0[r + 3]); a = fmaxf(fmaxf(a, p1[r]), p1[r + 1]); b = fmaxf(fmaxf(b, p1[r + 2]), p1[r + 3]); }
    float pmax = fmaxf(a, b);
    { auto rr = __builtin_amdgcn_permlane32_swap(__float_as_uint(pmax), __float_as_uint(pmax), false, false); pmax = fmaxf(__uint_as_float(rr[0]), __uint_as_float(rr[1])); }
    if (FIRST || !__all(pmax <= THR_L2)) {
        const float dl = FIRST ? pmax : fmaxf(pmax, 0.f);
        alpha = FIRST ? 0.f : __builtin_amdgcn_exp2f(-dl); m += dl;
#pragma unroll
        for (int r = 0; r < 16; ++r) { p0[r] -= dl; p1[r] -= dl; }
        const float nm = -m;
#pragma unroll
        for (int r = 0; r < 16; ++r) negm[r] = nm;
    } else alpha = 1.f;
#pragma unroll
    for (int r = 0; r < 16; ++r) p0[r] = __builtin_amdgcn_exp2f(p0[r]);
}
__device__ __forceinline__ void fsm2(f32x16& p0, f32x16& p1, float alpha, float& l_reg, bf16x8& pa0, bf16x8& pa1, bf16x8& pa2, bf16x8& pa3) {
#pragma unroll
    for (int r = 0; r < 16; ++r) p1[r] = __builtin_amdgcn_exp2f(p1[r]);
    f32x2 acc2 = {p0[0], p0[1]};
#pragma unroll
    for (int i = 1; i < 8; ++i) acc2 += (f32x2){p0[2 * i], p0[2 * i + 1]};
#pragma unroll
    for (int i = 0; i < 8; ++i) acc2 += (f32x2){p1[2 * i], p1[2 * i + 1]};
    float ps = acc2[0] + acc2[1];
    { auto rr = __builtin_amdgcn_permlane32_swap(__float_as_uint(ps), __float_as_uint(ps), false, false); ps = __uint_as_float(rr[0]) + __uint_as_float(rr[1]); }
    l_reg = l_reg * alpha + ps;
#define PK4(P, BASE, OUT) do { u32x4 w = {pk2(P[BASE + 0], P[BASE + 1]), pk2(P[BASE + 2], P[BASE + 3]), pk2(P[BASE + 4], P[BASE + 5]), pk2(P[BASE + 6], P[BASE + 7])}; \
    OUT = *reinterpret_cast<bf16x8*>(&w); } while (0)
    PK4(p0, 0, pa0); PK4(p0, 8, pa1); PK4(p1, 0, pa2); PK4(p1, 8, pa3);
#undef PK4
}
__device__ __forceinline__ float psm_max(const f32x16& p0, const f32x16& p1) {
    float a = fmaxf(fmaxf(p0[0], p0[1]), p1[0]), b = fmaxf(fmaxf(p0[2], p0[3]), p1[1]); a = fmaxf(fmaxf(a, p1[2]), p1[3]);
#pragma unroll
    for (int r = 4; r < 16; r += 4) { a = fmaxf(fmaxf(a, p0[r]), p0[r + 1]); b = fmaxf(fmaxf(b, p0[r + 2]), p0[r + 3]); a = fmaxf(fmaxf(a, p1[r]), p1[r + 1]); b = fmaxf(fmaxf(b, p1[r + 2]), p1[r + 3]); }
    return fmaxf(a, b);
}
__device__ __forceinline__ void psm_decide(f32x16& p0, f32x16& p1, float pmax, float& m, f32x16& negm, float& alpha) {
    { auto rr = __builtin_amdgcn_permlane32_swap(__float_as_uint(pmax), __float_as_uint(pmax), false, false); pmax = fmaxf(__uint_as_float(rr[0]), __uint_as_float(rr[1])); }
    if (!__all(pmax <= THR_L2)) {
        const float dl = fmaxf(pmax, 0.f);
        alpha = __builtin_amdgcn_exp2f(-dl); m += dl;
#pragma unroll
        for (int r = 0; r < 16; ++r) { p0[r] -= dl; p1[r] -= dl; }
        const float nm = -m;
#pragma unroll
        for (int r = 0; r < 16; ++r) negm[r] = nm;
    } else alpha = 1.f;
}
template <int LO, int HI> __device__ __forceinline__ void psm_exp(f32x16& p) {
#pragma unroll
    for (int r = LO; r < HI; ++r) p[r] = __builtin_amdgcn_exp2f(p[r]);
}
__device__ __forceinline__ void fsm3(f32x16& p0, f32x16& p1, float alpha, float& l_reg, bf16x8& pa0, bf16x8& pa1, bf16x8& pa2, bf16x8& pa3) {
    f32x2 s0 = {p0[0], p0[1]}, s1 = {p0[2], p0[3]}, s2 = {p1[0], p1[1]}, s3 = {p1[2], p1[3]};
#pragma unroll
    for (int i = 1; i < 4; ++i) { s0 += (f32x2){p0[4 * i], p0[4 * i + 1]}; s1 += (f32x2){p0[4 * i + 2], p0[4 * i + 3]}; s2 += (f32x2){p1[4 * i], p1[4 * i + 1]}; s3 += (f32x2){p1[4 * i + 2], p1[4 * i + 3]}; }
    s0 += s1; s2 += s3; s0 += s2;
    l_reg += s0[0] + s0[1];
#define PK4(P, BASE, OUT) do { u32x4 w = {pk2(P[BASE + 0], P[BASE + 1]), pk2(P[BASE + 2], P[BASE + 3]), pk2(P[BASE + 4], P[BASE + 5]), pk2(P[BASE + 6], P[BASE + 7])}; \
    OUT = *reinterpret_cast<bf16x8*>(&w); } while (0)
    PK4(p0, 0, pa0); PK4(p0, 8, pa1); PK4(p1, 0, pa2); PK4(p1, 8, pa3);
#undef PK4
}
__device__ __forceinline__ int v_st(int k, int c) { const int kk = (k & ~0xC) | ((k & 4) << 1) | ((k & 8) >> 1); return ((kk >> 3) * 4 + (c >> 5)) * 512 + ((kk & 7) * 32 + (c & 31)) * 2; }
__device__ __forceinline__ int v_rd_base(int lane) { return ((lane & 3) << 3) | (((lane >> 2) & 3) << 6) | (((lane >> 4) & 1) << 5) | (((lane >> 5) & 1) << 8); }
constexpr int v_rd_off(int d0, int ks, int half) { return d0 * 512 + ks * 4096 + half * 2048; }
template <int OFF> __device__ __forceinline__ s16x4 tr_read(int vb) { s16x4 r; asm volatile("ds_read_b64_tr_b16 %0, %1 offset:%2" : "=&v"(r) : "v"(vb), "i"(OFF) : "memory"); return r; }
template <int D0> __device__ __forceinline__ void pv_one(f32x16& od, int vb, bf16x8 pa0, bf16x8 pa1, bf16x8 pa2, bf16x8 pa3) {
    const s16x4 l0 = tr_read<v_rd_off(D0, 0, 0)>(vb), h0 = tr_read<v_rd_off(D0, 0, 1)>(vb), l1 = tr_read<v_rd_off(D0, 1, 0)>(vb), h1 = tr_read<v_rd_off(D0, 1, 1)>(vb);
    const s16x4 l2 = tr_read<v_rd_off(D0, 2, 0)>(vb), h2 = tr_read<v_rd_off(D0, 2, 1)>(vb), l3 = tr_read<v_rd_off(D0, 3, 0)>(vb), h3 = tr_read<v_rd_off(D0, 3, 1)>(vb);
    asm volatile("s_waitcnt lgkmcnt(0)" ::: "memory"); SBAR();
#define PK(L, H) (bf16x8){L[0], L[1], L[2], L[3], H[0], H[1], H[2], H[3]}
    od = __builtin_amdgcn_mfma_f32_32x32x16_bf16(pa0, PK(l0, h0), od, 0, 0, 0);
    od = __builtin_amdgcn_mfma_f32_32x32x16_bf16(pa1, PK(l1, h1), od, 0, 0, 0);
    od = __builtin_amdgcn_mfma_f32_32x32x16_bf16(pa2, PK(l2, h2), od, 0, 0, 0);
    od = __builtin_amdgcn_mfma_f32_32x32x16_bf16(pa3, PK(l3, h3), od, 0, 0, 0);
#undef PK
}
typedef short v4i16_t __attribute__((ext_vector_type(4)));
__device__ __forceinline__ s16x4 vtr(const LAS char* p) { return __builtin_bit_cast(s16x4, __builtin_amdgcn_ds_read_tr16_b64_v4i16((LAS v4i16_t*)p)); }
template <int D0, int KS> __device__ __forceinline__ bf16x8 vfrag(const LAS char* vp) {
    const s16x4 lo = vtr(vp + v_rd_off(D0, KS, 0)), hi = vtr(vp + v_rd_off(D0, KS, 1));
    return (bf16x8){lo[0], lo[1], lo[2], lo[3], hi[0], hi[1], hi[2], hi[3]};
}
#define SGB_MFMA(n) __builtin_amdgcn_sched_group_barrier(0x008, (n), 0)
#define SGB_DSR(n)  __builtin_amdgcn_sched_group_barrier(0x100, (n), 0)
#define SGB_VALU(n) __builtin_amdgcn_sched_group_barrier(0x002, (n), 0)
#define SGB_TRANS(n) __builtin_amdgcn_sched_group_barrier(0x400, (n), 0)
template <int KS> __device__ __forceinline__ void pv_ks(f32x16* o, int vb, bf16x8 pa) {
    const s16x4 l0 = tr_read<v_rd_off(0, KS, 0)>(vb), h0 = tr_read<v_rd_off(0, KS, 1)>(vb), l1 = tr_read<v_rd_off(1, KS, 0)>(vb), h1 = tr_read<v_rd_off(1, KS, 1)>(vb);
    const s16x4 l2 = tr_read<v_rd_off(2, KS, 0)>(vb), h2 = tr_read<v_rd_off(2, KS, 1)>(vb), l3 = tr_read<v_rd_off(3, KS, 0)>(vb), h3 = tr_read<v_rd_off(3, KS, 1)>(vb);
    asm volatile("s_waitcnt lgkmcnt(0)" ::: "memory"); SBAR();
#define PK(L, H) (bf16x8){L[0], L[1], L[2], L[3], H[0], H[1], H[2], H[3]}
    o[0] = __builtin_amdgcn_mfma_f32_32x32x16_bf16(pa, PK(l0, h0), o[0], 0, 0, 0);
    o[1] = __builtin_amdgcn_mfma_f32_32x32x16_bf16(pa, PK(l1, h1), o[1], 0, 0, 0);
    o[2] = __builtin_amdgcn_mfma_f32_32x32x16_bf16(pa, PK(l2, h2), o[2], 0, 0, 0);
    o[3] = __builtin_amdgcn_mfma_f32_32x32x16_bf16(pa, PK(l3, h3), o[3], 0, 0, 0);
#undef PK
}
__device__ __forceinline__ void pv_d0(f32x16* o, int vb, bf16x8 pa0, bf16x8 pa1, bf16x8 pa2, bf16x8 pa3) {
    pv_ks<0>(o, vb, pa0); pv_ks<1>(o, vb, pa1); pv_ks<2>(o, vb, pa2); pv_ks<3>(o, vb, pa3);
}
template <int CH> __device__ __forceinline__ void na_fix_exp(f32x16& p0, f32x16& p1, unsigned vm, const float* bt) {
#pragma unroll
    for (int r = 0; r < 16; ++r) { const int ko = (r & 3) + 8 * (r >> 2);
        const bool l0 = (CH == 0) || (r >= 12), l1 = (CH == 1) || (r < 4);
        if (l0) p0[r] = __builtin_amdgcn_exp2f(((vm >> r) & 1u) ? p0[r] + bt[ko] : -30000.f); else p0[r] = 0.f;
        if (l1) p1[r] = __builtin_amdgcn_exp2f(((vm >> (16 + r)) & 1u) ? p1[r] + bt[32 + ko] : -30000.f); else p1[r] = 0.f; }
}
template <int CH> __device__ __forceinline__ void na_finish(const f32x16& p0, const f32x16& p1, float& l_reg, bf16x8& pa0, bf16x8& pa1, bf16x8& pa2, bf16x8& pa3) {
    float ps = 0.f;
#pragma unroll
    for (int r = 0; r < 16; ++r) { if ((CH == 0) || (r >= 12)) ps += p0[r]; if ((CH == 1) || (r < 4)) ps += p1[r]; }
    l_reg += ps;
#define PKD(P, BASE, OUT) do { u32x4 w = {pk2(P[BASE + 0], P[BASE + 1]), pk2(P[BASE + 2], P[BASE + 3]), pk2(P[BASE + 4], P[BASE + 5]), pk2(P[BASE + 6], P[BASE + 7])}; OUT = *reinterpret_cast<bf16x8*>(&w); } while (0)
    if constexpr (CH == 0) { PKD(p0, 0, pa0); PKD(p0, 8, pa1); PKD(p1, 0, pa2); pa3 = pa2; }
    else { PKD(p0, 8, pa1); PKD(p1, 0, pa2); PKD(p1, 8, pa3); pa0 = pa1; }
#undef PKD
}
template <int CH, int COMP> __device__ __forceinline__ void na_pv(f32x16* o, const LAS char* vp, bf16x8 pa0, bf16x8 pa1, bf16x8 pa2, bf16x8 pa3) {
#define NA_KS(KS, PA) do { const bf16x8 f0 = vfrag<2 * COMP, KS>(vp), f1 = vfrag<2 * COMP + 1, KS>(vp); \
        o[0] = __builtin_amdgcn_mfma_f32_32x32x16_bf16(PA, f0, o[0], 0, 0, 0); o[1] = __builtin_amdgcn_mfma_f32_32x32x16_bf16(PA, f1, o[1], 0, 0, 0); } while (0)
    if constexpr (CH == 0) { NA_KS(0, pa0); NA_KS(1, pa1); NA_KS(2, pa2); } else { NA_KS(1, pa1); NA_KS(2, pa2); NA_KS(3, pa3); }
#undef NA_KS
}
constexpr int L2_K = 0, L2_V = 3 * 16384, L2_WS = 6 * 16384, L2_BIAS = L2_WS + 2048, L2_END = L2_BIAS + 8 * 465 * 4;
template <int MODE>
__device__ __forceinline__ void attn_unit2(const bf16* __restrict__ Qb, const bf16* __restrict__ Kh, const bf16* __restrict__ Vh, bf16_t* __restrict__ Ob,
                                           const float lam, const float* __restrict__ subg, const int NT, char* lds,
                                           const int r0, const int R0, const int hp, const float* bias8, const volatile LAS unsigned* kmw) {
    constexpr int ND = MODE ? 2 : 4;
    const int tid = threadIdx.x, wid = __builtin_amdgcn_readfirstlane(tid >> 6), lane = tid & 63, r32 = lane & 31, hi = lane >> 5;
    const int comp = wid >> 2, qg = wid & 3;
    float* ws = (float*)(lds + L2_WS) + wid * 64; float* li_l = ws; float* al_l = ws + 32;
    float m_reg = 0.f, l_reg = 0; f32x16 o[ND] = {}; f32x16 negm = {}; bf16x8 qr[4];
    const bf16* Qw = Qb + (long)(qg * QBLK + r32) * LDK + comp * 64 + hi * 8;
#pragma unroll
    for (int d0 = 0; d0 < 4; ++d0) qr[d0] = *reinterpret_cast<const bf16x8*>(Qw + d0 * 16);
    if constexpr (MODE == 0) {
        float qs = 0.f;
#pragma unroll
        for (int d0 = 0; d0 < 4; ++d0)
#pragma unroll
            for (int j = 0; j < 8; ++j) { const float x = __uint_as_float((unsigned)(unsigned short)qr[d0][j] << 16); qs = fmaf(x, x, qs); }
        { auto rr = __builtin_amdgcn_permlane32_swap(__float_as_uint(qs), __float_as_uint(qs), false, false); qs = __uint_as_float(rr[0]) + __uint_as_float(rr[1]); }
        const float km2 = __uint_as_float(kmw[comp * 2]) + __uint_as_float(kmw[comp * 2 + 1]);
        const float ref = fminf(sqrtf(qs * km2) * 1.02f + 0.01f, 64.f);
#pragma unroll
        for (int r = 0; r < 16; ++r) negm[r] = -ref;
    }
    unsigned vmask = 0u; const float* bt0 = bias8; int rimg = 0;
    if constexpr (MODE == 1) {
        const int c = (qg & 1) * 32 + r32, cs0 = min(max(c - 8, 0), 48); rimg = r0 + (qg >> 1);
#pragma unroll
        for (int r = 0; r < 16; ++r) { const int kc = crow(r, hi); if ((unsigned)(kc - cs0) < 16u) vmask |= 1u << r; if ((unsigned)(kc + 32 - cs0) < 16u) vmask |= 1u << (16 + r); }
        bt0 = bias8 + (hp * 2 + comp) * 465 + (15 - c + 4 * hi);
    }
    const int rs_w = min(max(rimg - 4, 0), 120);
    const int ch = qg & 1;
    if constexpr (MODE == 1) {
        float qs = 0.f;
#pragma unroll
        for (int d0 = 0; d0 < 4; ++d0)
#pragma unroll
            for (int j = 0; j < 8; ++j) { const float x = __uint_as_float((unsigned)(unsigned short)qr[d0][j] << 16); qs = fmaf(x, x, qs); }
        { auto rr = __builtin_amdgcn_permlane32_swap(__float_as_uint(qs), __float_as_uint(qs), false, false); qs = __uint_as_float(rr[0]) + __uint_as_float(rr[1]); }
        const float km2 = __uint_as_float(kmw[comp * 2]) + __uint_as_float(kmw[comp * 2 + 1]);
        const float ref = fminf(sqrtf(qs * km2) * 1.02f + lam + 0.01f, 64.f);
#pragma unroll
        for (int r = 0; r < 16; ++r) negm[r] = -ref;
    }
    unsigned koff[2], voff[2];
#pragma unroll
    for (int i = 0; i < 2; ++i) { const int jj = 2 * wid + i;
        { const int row = 4 * jj + (lane >> 4), c16 = (lane & 15) ^ (row & 7); koff[i] = (unsigned)(row * 1024 + c16 * 16); }
        { const int st = 2 * jj + (lane >> 5), w = (lane & 31) * 16, kk = (st >> 2) * 8 + (w >> 6), k = kk, c = (st & 3) * 32 + ((w & 63) >> 4) * 8;
          voff[i] = (unsigned)(k * 1024 + c * 2); } }
    LAS unsigned char* ldsl = (LAS unsigned char*)lds;
    const unsigned pw = (unsigned)wid * 2048u;
#define KROW2(t) ((MODE ? (min(R0 + min((t), NT - 1), 127) * 64) : (min((t), NT - 1) * KVBLK)))
#define DMAK(t, slot) do { const char* g_ = (const char*)Kh + (size_t)KROW2(t) * 1024; _Pragma("unroll") for (int i_ = 0; i_ < 2; ++i_) \
        __builtin_amdgcn_global_load_lds((const unsigned*)(g_ + koff[i_]), (LAS unsigned*)(ldsl + L2_K + (slot) * 16384 + pw + i_ * 1024), 16, 0, 0); } while (0)
#define DMAV(t, slot) do { const char* g_ = (const char*)Vh + (size_t)KROW2(t) * 1024; _Pragma("unroll") for (int i_ = 0; i_ < 2; ++i_) \
        __builtin_amdgcn_global_load_lds((const unsigned*)(g_ + voff[i_]), (LAS unsigned*)(ldsl + L2_V + (slot) * 16384 + pw + i_ * 1024), 16, 0, 0); } while (0)
#define WAITBAR(N) asm volatile("s_waitcnt vmcnt(" #N ") lgkmcnt(0)\n\ts_barrier" ::: "memory")
#define FIXUP(P0, P1, t) do { if constexpr (MODE == 1) { const int trow = R0 + (t); const bool tv = (trow >= rs_w) && (trow < rs_w + 8); const unsigned vm = tv ? vmask : 0u; \
        const int ro = min(max(trow - rimg + 7, 0), 14); const float* bt = bt0 + ro * 31; \
        if (ch == 0) na_fix_exp<0>(P0, P1, vm, bt); else na_fix_exp<1>(P0, P1, vm, bt); } } while (0)
#define PVALL(vb) do { if constexpr (MODE == 0) { pv_d0(o, (vb), pa0, pa1, pa2, pa3); } else { \
        if (comp == 0) { pv_one<0>(o[0], (vb), pa0, pa1, pa2, pa3); pv_one<1>(o[1], (vb), pa0, pa1, pa2, pa3); } \
        else { pv_one<2>(o[0], (vb), pa0, pa1, pa2, pa3); pv_one<3>(o[1], (vb), pa0, pa1, pa2, pa3); } } } while (0)
#define RESC(a) do { if (__any((a) < 1.f)) { if (hi == 0) al_l[r32] = (a); asm volatile("s_waitcnt lgkmcnt(0)" ::: "memory"); \
    _Pragma("unroll") for (int d = 0; d < ND; ++d) _Pragma("unroll") for (int r = 0; r < 16; ++r) o[d][r] *= al_l[crow(r, hi)]; } } while (0)
    const int vb0 = (int)(uintptr_t)(lds + L2_V) + v_rd_base(lane);
    const char* Kc = (const char*)lds + L2_K + comp * 128;
    f32x16 pA0, pA1, pB0, pB1; float mnA, mnB, alA = 1.f, alB = 1.f; bf16x8 pa0, pa1, pa2, pa3;
    DMAK(0, 0); DMAV(0, 0); DMAK(1, 1); DMAK(2, 2); DMAV(1, 1);
    WAITBAR(4);
    qkt2(pA0, pA1, Kc, qr, negm, r32, hi); FIXUP(pA0, pA1, 0); if constexpr (MODE == 0) { psm_exp<0, 16>(pA0); psm_exp<0, 16>(pA1); }
    asm volatile("s_waitcnt lgkmcnt(0)\n\ts_barrier" ::: "memory");
    int sp = 2, sc = 0, sn = 1;
#define ITER(C0, C1, alC, N0, N1, mnN, alN, t, HASNEXT) do { \
        DMAK((t) + 3, sc); DMAV((t) + 2, sp); \
        SBAR(); if (HASNEXT) { qkt2(N0, N1, Kc + sn * 16384, qr, negm, r32, hi); FIXUP(N0, N1, (t) + 1); } \
        if constexpr (MODE == 0) { fsm3(C0, C1, alC, l_reg, pa0, pa1, pa2, pa3); \
            SGB_DSR(8); _Pragma("unroll") for (int g_ = 0; g_ < 8; ++g_) { SGB_MFMA(1); SGB_VALU(5); } SBAR(); \
            const int vb_ = vb0 + sc * 16384; float pm_ = 0.f; \
            const LAS char* vp_ = (const LAS char*)(unsigned)vb_; \
              \
            { const bf16x8 f0 = vfrag<0, 0>(vp_), f1 = vfrag<1, 0>(vp_), f2 = vfrag<2, 0>(vp_), f3 = vfrag<3, 0>(vp_); \
              o[0] = __builtin_amdgcn_mfma_f32_32x32x16_bf16(pa0, f0, o[0], 0, 0, 0); o[1] = __builtin_amdgcn_mfma_f32_32x32x16_bf16(pa0, f1, o[1], 0, 0, 0); \
              o[2] = __builtin_amdgcn_mfma_f32_32x32x16_bf16(pa0, f2, o[2], 0, 0, 0); o[3] = __builtin_amdgcn_mfma_f32_32x32x16_bf16(pa0, f3, o[3], 0, 0, 0); \
              (void)pm_; } \
              \
            { const bf16x8 g0 = vfrag<0, 1>(vp_), g1 = vfrag<1, 1>(vp_), g2 = vfrag<2, 1>(vp_), g3 = vfrag<3, 1>(vp_); \
              o[0] = __builtin_amdgcn_mfma_f32_32x32x16_bf16(pa1, g0, o[0], 0, 0, 0); o[1] = __builtin_amdgcn_mfma_f32_32x32x16_bf16(pa1, g1, o[1], 0, 0, 0); \
              o[2] = __builtin_amdgcn_mfma_f32_32x32x16_bf16(pa1, g2, o[2], 0, 0, 0); o[3] = __builtin_amdgcn_mfma_f32_32x32x16_bf16(pa1, g3, o[3], 0, 0, 0); \
              const bf16x8 h0 = vfrag<0, 2>(vp_), h1 = vfrag<1, 2>(vp_), h2 = vfrag<2, 2>(vp_), h3 = vfrag<3, 2>(vp_); \
              o[0] = __builtin_amdgcn_mfma_f32_32x32x16_bf16(pa2, h0, o[0], 0, 0, 0); o[1] = __builtin_amdgcn_mfma_f32_32x32x16_bf16(pa2, h1, o[1], 0, 0, 0); \
              o[2] = __builtin_amdgcn_mfma_f32_32x32x16_bf16(pa2, h2, o[2], 0, 0, 0); o[3] = __builtin_amdgcn_mfma_f32_32x32x16_bf16(pa2, h3, o[3], 0, 0, 0); \
              const bf16x8 i0 = vfrag<0, 3>(vp_), i1 = vfrag<1, 3>(vp_), i2 = vfrag<2, 3>(vp_), i3 = vfrag<3, 3>(vp_); \
              o[0] = __builtin_amdgcn_mfma_f32_32x32x16_bf16(pa3, i0, o[0], 0, 0, 0); o[1] = __builtin_amdgcn_mfma_f32_32x32x16_bf16(pa3, i1, o[1], 0, 0, 0); \
              o[2] = __builtin_amdgcn_mfma_f32_32x32x16_bf16(pa3, i2, o[2], 0, 0, 0); o[3] = __builtin_amdgcn_mfma_f32_32x32x16_bf16(pa3, i3, o[3], 0, 0, 0); \
              if (HASNEXT) { psm_exp<0, 16>(N0); psm_exp<0, 16>(N1); } \
              SGB_DSR(8); \
              _Pragma("unroll") for (int g_ = 0; g_ < 12; ++g_) { SGB_MFMA(1); SGB_DSR(2); SGB_TRANS(2); } \
              SGB_MFMA(1); SGB_TRANS(2); SGB_MFMA(1); SGB_TRANS(2); SGB_MFMA(1); SGB_TRANS(2); SGB_MFMA(1); SGB_TRANS(2); \
              if (HASNEXT) asm volatile("" : "+v"(N0), "+v"(N1)); } \
        } else { if (ch == 0) na_finish<0>(C0, C1, l_reg, pa0, pa1, pa2, pa3); else na_finish<1>(C0, C1, l_reg, pa0, pa1, pa2, pa3); SBAR(); \
            const LAS char* vp_ = (const LAS char*)(unsigned)(vb0 + sc * 16384); \
            if (ch == 0) { if (comp == 0) na_pv<0, 0>(o, vp_, pa0, pa1, pa2, pa3); else na_pv<0, 1>(o, vp_, pa0, pa1, pa2, pa3); } \
            else { if (comp == 0) na_pv<1, 0>(o, vp_, pa0, pa1, pa2, pa3); else na_pv<1, 1>(o, vp_, pa0, pa1, pa2, pa3); } } \
        WAITBAR(4); \
        sp = sc; sc = sn; sn = (sn == 2) ? 0 : sn + 1; } while (0)
    for (int t = 0; t < NT; t += 2) {
        const bool has1 = (t + 1 < NT);
        ITER(pA0, pA1, alA, pB0, pB1, mnB, alB, t, has1);
        if (!has1) break;
        const bool hn = (t + 2 < NT);
        ITER(pB0, pB1, alB, pA0, pA1, mnA, alA, t + 1, hn);
    }
    asm volatile("s_waitcnt vmcnt(0)" ::: "memory");
    const int lane_e = lane_now(), r32e = lane_e & 31, hie = lane_e >> 5;
    { auto rr = __builtin_amdgcn_permlane32_swap(__float_as_uint(l_reg), __float_as_uint(l_reg), false, false); l_reg = __uint_as_float(rr[0]) + __uint_as_float(rr[1]); }
    if (hie == 0) li_l[r32e] = l_reg; asm volatile("s_waitcnt lgkmcnt(0)" ::: "memory");
    float rli[16];
#pragma unroll
    for (int r = 0; r < 16; ++r) rli[r] = __builtin_amdgcn_rcpf(li_l[crow(r, hie)]);
    if constexpr (MODE == 0) {
        __syncthreads();
        float* X = (float*)lds + qg * 4096;
        if (comp == 1) {
#pragma unroll
            for (int d0 = 0; d0 < 4; ++d0)
#pragma unroll
                for (int r = 0; r < 16; ++r) X[(d0 * 16 + r) * 64 + lane_e] = o[d0][r] * rli[r] * lam;
        }
        __syncthreads();
        if (comp == 0) {
            float ss[16];
#pragma unroll
            for (int r = 0; r < 16; ++r) ss[r] = 0.f;
#pragma unroll
            for (int d0 = 0; d0 < 4; ++d0)
#pragma unroll
                for (int r = 0; r < 16; ++r) { const float v = o[d0][r] * rli[r] - X[(d0 * 16 + r) * 64 + lane_e]; o[d0][r] = v; ss[r] += v * v; }
#pragma unroll
            for (int r = 0; r < 16; ++r) {
#pragma unroll
                for (int msk = 1; msk < 32; msk <<= 1) ss[r] += __shfl_xor(ss[r], msk);
                ss[r] = (1.0f - LAM_INIT) / sqrtf(ss[r] * (1.0f / 128.0f) + RMS_EPS);
            }
            float gg[4];
#pragma unroll
            for (int d0 = 0; d0 < 4; ++d0) gg[d0] = subg[d0 * 32 + r32e];
            bf16_t* Ow = Ob + (long)(qg * QBLK) * OLD;
#pragma unroll
            for (int r = 0; r < 16; ++r) { const int orow = crow(r, hie);
#pragma unroll
                for (int d0 = 0; d0 < 4; ++d0) { const float v = o[d0][r] * ss[r] * gg[d0]; Ow[(long)orow * OLD + d0 * 32 + r32e] = (bf16_t)(pk2(v, v) & 0xffffu); } }
        }
    } else {
        bf16_t* Ow = Ob + (long)(qg * QBLK) * OLD + comp * 64;
#pragma unroll
        for (int r = 0; r < 16; ++r) { const int orow = crow(r, hie);
#pragma unroll
            for (int d0 = 0; d0 < 2; ++d0) { const float v = o[d0][r] * rli[r]; Ow[(long)orow * OLD + d0 * 32 + r32e] = (bf16_t)(pk2(v, v) & 0xffffu); } }
    }
    __syncthreads();
#undef KROW2
#undef DMAK
#undef DMAV
#undef WAITBAR
#undef FIXUP
#undef PVALL
#undef RESC
#undef ITER
}
#undef KSWZ
#undef SBAR
}

#define XB_TMO      128
#define XB_XCNT(j)  (256  + 64 * (j))
#define XB_XSUB(j)  (1280 + 64 * (j))
#define XB_XGEN(j)  (2304 + 64 * (j))
#define XB_TOP      3328
#define XB_TOPGEN   3392
#define XCD_BAR_WORDS 3456
#define XB_SPIN_CAP (1u << 18)
__device__ __forceinline__ unsigned xb_ld(unsigned* p)              { return __hip_atomic_load(p, __ATOMIC_RELAXED, __HIP_MEMORY_SCOPE_AGENT); }
__device__ __forceinline__ unsigned xb_add(unsigned* p, unsigned v) { return __hip_atomic_fetch_add(p, v, __ATOMIC_RELAXED, __HIP_MEMORY_SCOPE_AGENT); }
__device__ __forceinline__ unsigned xb_xcc_id() { return (unsigned)__builtin_amdgcn_s_getreg((3 << 11) | 20) & 0xFu; }
#define XB_SPIN(cond, bar) do { unsigned _sp = 0; while (cond) { __builtin_amdgcn_s_sleep(1); \
    if ((++_sp & 255u) == 0u) { if (xb_ld(&(bar)[XB_TMO])) break; if (_sp > XB_SPIN_CAP) { atomicAdd(&(bar)[XB_TMO], 1u); break; } } } } while (0)
struct XcdBarrier { unsigned* bar; unsigned x; volatile LAS unsigned* st; };
__device__ __forceinline__ XcdBarrier xcd_barrier_post(unsigned* bar, volatile LAS unsigned* st) {
    XcdBarrier b; b.bar = bar; b.x = xb_xcc_id(); b.st = st;
    if (threadIdx.x == 0) (void)xb_add(&bar[XB_XCNT(b.x)], 1u);
    return b;
}
__device__ __forceinline__ void xcd_barrier_complete(unsigned* bar, unsigned x, unsigned& nloc, unsigned& nx) {
    const unsigned G = gridDim.x * gridDim.y * gridDim.z;
    unsigned sum, cnt, mine, sp = 0u;
    for (;;) {
        sum = 0u; cnt = 0u; mine = 0u;
#pragma unroll
        for (unsigned j = 0; j < 16; ++j) { const unsigned c = xb_ld(&bar[XB_XCNT(j)]); sum += c; cnt += (c > 0u) ? 1u : 0u; mine = (j == x) ? c : mine; }
        if (sum == G) break;
        __builtin_amdgcn_s_sleep(1);
        if ((++sp & 255u) == 0u) { if (xb_ld(&bar[XB_TMO])) break; if (sp > XB_SPIN_CAP) { atomicAdd(&bar[XB_TMO], 1u); break; } }
    }
    nloc = mine > 0u ? mine : 1u; nx = cnt > 0u ? cnt : 1u;
}
__device__ __forceinline__ void xcd_barrier(const XcdBarrier& b) {
    asm volatile("s_waitcnt vmcnt(0)" ::: "memory");
    __syncthreads();
    if (threadIdx.x == 0) {
        unsigned* bar = b.bar;
        __builtin_amdgcn_s_waitcnt(0);
        unsigned nloc = b.st[0], nx = b.st[1];
        if (nloc == 0u) { xcd_barrier_complete(bar, b.x, nloc, nx); b.st[0] = nloc; b.st[1] = nx; }
        const unsigned old = xb_add(&bar[XB_XSUB(b.x)], 1u);
        const unsigned gen = old / nloc;
        if (old + 1u == (gen + 1u) * nloc) {
            __builtin_amdgcn_fence(__ATOMIC_RELEASE, "agent");
            asm volatile("s_waitcnt vmcnt(0)" ::: "memory");
            const unsigned og = xb_add(&bar[XB_TOP], 1u);
            const unsigned tg = og / nx;
            if (og + 1u == (tg + 1u) * nx) xb_add(&bar[XB_TOPGEN], 1u);
            else XB_SPIN(xb_ld(&bar[XB_TOPGEN]) == tg, bar);
            __builtin_amdgcn_fence(__ATOMIC_ACQUIRE, "agent");
            xb_add(&bar[XB_XGEN(b.x)], 1u);
            asm volatile("s_waitcnt vmcnt(0)" ::: "memory");
        } else {
            XB_SPIN(xb_ld(&bar[XB_XGEN(b.x)]) == gen, bar);
            __builtin_amdgcn_fence(__ATOMIC_ACQUIRE, "agent");
            asm volatile("s_waitcnt vmcnt(0)" ::: "memory");
        }
    }
    __syncthreads();
}

struct Args {
    const float *x, *w_in, *b_in, *lq1, *lk1, *lq2, *lk2, *subg, *rpb, *wda, *wna, *wout, *ln1g, *ln1b, *wr, *br, *w1, *b1, *w2, *b2, *ln2g, *ln2b;
    float* out; unsigned char* ws; int ph_lo, ph_hi;
};
struct Frame {
    LAS unsigned char* lds; volatile LAS unsigned* MISC; unsigned* ctl;
    int tid, lane, wave, G;
};

#ifndef MOE_IN_P2
#define MOE_IN_P2 1
#endif
template <class SrcCol>
__device__ __forceinline__ void transpose_item(const float* W, int K, int N, bf16_t* WT, LAS float* scr, int item, int lane, SrcCol sc, int ldk = 0) {
    if (ldk == 0) ldk = K;
    const int nblk = N / 32, kb = item / nblk, nb = item % nblk, k0 = 64 * kb, n0 = 32 * nb;
    const int scol = sc(n0 + (lane & 31));
    float wv[32];
#pragma unroll
    for (int i = 0; i < 32; ++i) { const int kk = 2 * i + (lane >> 5); wv[i] = W[(size_t)(k0 + kk) * N + scol]; }
#pragma unroll
    for (int i = 0; i < 32; ++i) { const int kk = 2 * i + (lane >> 5); scr[kk * 33 + (lane & 31)] = wv[i]; }
    LDS_WAIT(); asm volatile("" ::: "memory");
    const int c = lane & 7;
#pragma unroll
    for (int j = 0; j < 4; ++j) { const int n = (lane >> 3) + 8 * j; const LAS float* s = scr + (8 * c) * 33 + n;
        u32x4 o; o.x = pk2(s[0 * 33], s[1 * 33]); o.y = pk2(s[2 * 33], s[3 * 33]); o.z = pk2(s[4 * 33], s[5 * 33]); o.w = pk2(s[6 * 33], s[7 * 33]);
        *(GAS u32x4*)(WT + (size_t)(n0 + n) * ldk + k0 + 8 * c) = o; }
    LDS_WAIT(); asm volatile("" ::: "memory");
}
template <class SrcCol>
__device__ __forceinline__ void transpose_item_fp8(const float* W, int K, int N, unsigned char* WT, LAS float* scr, int item, int lane, SrcCol sc) {
    const int nblk = N / 32, kb = item / nblk, nb = item % nblk, k0 = 64 * kb, n0 = 32 * nb;
    const int scol = sc(n0 + (lane & 31));
    float wv[32];
#pragma unroll
    for (int i = 0; i < 32; ++i) { const int kk = 2 * i + (lane >> 5); wv[i] = W[(size_t)(k0 + kk) * N + scol]; }
#pragma unroll
    for (int i = 0; i < 32; ++i) { const int kk = 2 * i + (lane >> 5); scr[kk * 33 + (lane & 31)] = wv[i]; }
    LDS_WAIT(); asm volatile("" ::: "memory");
    const int c = lane & 3;
#pragma unroll
    for (int j = 0; j < 2; ++j) { const int n = (lane >> 2) + 16 * j; const LAS float* s = scr + (16 * c) * 33 + n;
        u32x4 o;
        o.x = pk4_fp8(s[0 * 33] * WSCALE, s[1 * 33] * WSCALE, s[2 * 33] * WSCALE, s[3 * 33] * WSCALE); o.y = pk4_fp8(s[4 * 33] * WSCALE, s[5 * 33] * WSCALE, s[6 * 33] * WSCALE, s[7 * 33] * WSCALE);
        o.z = pk4_fp8(s[8 * 33] * WSCALE, s[9 * 33] * WSCALE, s[10 * 33] * WSCALE, s[11 * 33] * WSCALE); o.w = pk4_fp8(s[12 * 33] * WSCALE, s[13 * 33] * WSCALE, s[14 * 33] * WSCALE, s[15 * 33] * WSCALE);
        *(GAS u32x4*)(WT + (size_t)(n0 + n) * K + k0 + 16 * c) = o; }
    LDS_WAIT(); asm volatile("" ::: "memory");
}
__host__ __device__ __forceinline__ int src_in(int n) { return n < 1024 ? ((n & ~63) + ((n & 63) >> 1) + 32 * (n & 1)) : n; }
__host__ __device__ __forceinline__ int src_w1(int n) { const int pn = n >> 8, p = n & 255; return p < 128 ? 2 * (128 * pn + p) : 2 * (128 * pn + p - 128) + 1; }
struct SrcId { __device__ __forceinline__ int operator()(int n) const { return n; } };
struct SrcIn { __device__ __forceinline__ int operator()(int n) const { return src_in(n); } };
struct SrcW1 { __device__ __forceinline__ int operator()(int n) const { return src_w1(n); } };

template <bool W1MAP>
__device__ __forceinline__ void moe_patch(const float* __restrict__ W, const int N, unsigned char* __restrict__ WT, const int kb, const int cb, const int lane) {
    const int ng = lane & 15, kg = lane >> 4, k0 = 64 * kb + 16 * kg, c0 = 64 * cb + 4 * ng;
    f32x4 v[16];
#pragma unroll
    for (int i = 0; i < 16; ++i) v[i] = *(const f32x4*)(W + (size_t)(k0 + i) * N + c0);
#pragma unroll
    for (int j = 0; j < 4; ++j) {
        u32x4 o;
        o.x = pk4_fp8(v[0][j] * WSCALE, v[1][j] * WSCALE, v[2][j] * WSCALE, v[3][j] * WSCALE);     o.y = pk4_fp8(v[4][j] * WSCALE, v[5][j] * WSCALE, v[6][j] * WSCALE, v[7][j] * WSCALE);
        o.z = pk4_fp8(v[8][j] * WSCALE, v[9][j] * WSCALE, v[10][j] * WSCALE, v[11][j] * WSCALE);   o.w = pk4_fp8(v[12][j] * WSCALE, v[13][j] * WSCALE, v[14][j] * WSCALE, v[15][j] * WSCALE);
        const int sc = c0 + j;
        const int n = W1MAP ? ((sc & ~255) + ((sc & 255) >> 1) + 128 * (sc & 1)) : sc;
        *(GAS u32x4*)(WT + (size_t)n * DM + k0) = o;
    }
}
__device__ __forceinline__ void p0_moe(Frame& F, const Args& a) {
    F.lane = lane_now();
    unsigned char* ws = a.ws;
    const int gw = blockIdx.x * NWAVES + F.wave, NGW = F.G * NWAVES;
    constexpr int P1E = (DM / 128) * (2048 / 64), P2E = (DM / 128) * (DM / 64), NP1 = NE * P1E, NP2 = NE * P2E;
    for (int q = gw; q < NP1 + NP2; q += NGW) {
        if (q < NP1) { const int e = q / P1E, qi = q % P1E, kbp = qi >> 5, cb = qi & 31; const float* W = a.w1 + (size_t)e * DM * 2048; unsigned char* D = (unsigned char*)(ws + WS_W1) + (size_t)e * 2048 * DM;
            moe_patch<true>(W, 2048, D, 2 * kbp, cb, F.lane); moe_patch<true>(W, 2048, D, 2 * kbp + 1, cb, F.lane); }
        else { const int r = q - NP1, e = r / P2E, qi = r % P2E, kbp = qi >> 4, cb = qi & 15; const float* W = a.w2 + (size_t)e * DM * DM; unsigned char* D = (unsigned char*)(ws + WS_W2) + (size_t)e * DM * DM;
            moe_patch<false>(W, DM, D, 2 * kbp, cb, F.lane); moe_patch<false>(W, DM, D, 2 * kbp + 1, cb, F.lane); }
    }
}
__device__ __forceinline__ void p0_prologue(Frame& F, const Args& a) {
    F.lane = lane_now();
    unsigned char* ws = a.ws;
    LAS float* scr = (LAS float*)(F.lds + F.wave * 16384);
    const int gw = blockIdx.x * NWAVES + F.wave, NGW = F.G * NWAVES;
    constexpr int I_IN = (DM / 64) * (INC / 32), I_BR = (512 / 64) * (DM / 32), I_OUT = (DM / 64) * (DM / 32), I_W1E = (DM / 64) * (2048 / 32), I_W2E = (DM / 64) * (DM / 32);
    constexpr int NITEMS = I_IN + 2 * I_BR + I_OUT + (MOE_IN_P2 ? 0 : NE * I_W1E + NE * I_W2E);
    for (int it = gw; it < NITEMS; it += NGW) {
        int r = it;
        if (r < I_IN) { transpose_item_fp8(a.w_in, DM, INC, (unsigned char*)(ws + WS_WIN), scr, r, F.lane, SrcIn()); continue; } r -= I_IN;
        if (r < I_BR) { transpose_item(a.wda, 512, DM, (bf16_t*)(ws + WS_WDA), scr, r, F.lane, SrcId(), DM); continue; } r -= I_BR;
        if (r < I_BR) { transpose_item(a.wna, 512, DM, (bf16_t*)(ws + WS_WDA) + 512, scr, r, F.lane, SrcId(), DM); continue; } r -= I_BR;
        if (r < I_OUT) { transpose_item(a.wout, DM, DM, (bf16_t*)(ws + WS_WOUT), scr, r, F.lane, SrcId()); continue; } r -= I_OUT;
        if (r < NE * I_W1E) { const int e = r / I_W1E, ri = r % I_W1E; transpose_item_fp8(a.w1 + (size_t)e * DM * 2048, DM, 2048, (unsigned char*)(ws + WS_W1) + (size_t)e * 2048 * DM, scr, ri, F.lane, SrcW1()); continue; } r -= NE * I_W1E;
        { const int e = r / I_W2E, ri = r % I_W2E; transpose_item_fp8(a.w2 + (size_t)e * DM * DM, DM, DM, (unsigned char*)(ws + WS_W2) + (size_t)e * DM * DM, scr, ri, F.lane, SrcId()); }
    }
    const int gt = blockIdx.x * NTHR + F.tid, NGT = F.G * NTHR;
    { const f32x4* xs = (const f32x4*)a.x; u32x4* xd = (u32x4*)(ws + WS_XB);
      for (int i0 = gt; i0 < T * DM / 8; i0 += 4 * NGT) { f32x4 p[4], q[4];
#pragma unroll
          for (int u = 0; u < 4; ++u) { const int i = i0 + u * NGT; if (i < T * DM / 8) { p[u] = xs[2 * (size_t)i]; q[u] = xs[2 * (size_t)i + 1]; } }
#pragma unroll
          for (int u = 0; u < 4; ++u) { const int i = i0 + u * NGT; if (i < T * DM / 8) { u32x2 o; o.x = pk4_fp8(p[u][0] * XINSCALE, p[u][1] * XINSCALE, p[u][2] * XINSCALE, p[u][3] * XINSCALE); o.y = pk4_fp8(q[u][0] * XINSCALE, q[u][1] * XINSCALE, q[u][2] * XINSCALE, q[u][3] * XINSCALE); ((u32x2*)xd)[i] = o; } } } }
    { f32x2* cs = (f32x2*)(ws + WS_CS);
      for (int i = gt; i < SEQ * 32; i += NGT) { const int pos = i >> 5, fi = i & 31;
          double inv = 1.0; for (int k = 0; k < fi; ++k) inv *= 0.74989420933245582730;
          const double rev = (double)pos * inv * 0.15915494309189533577;
          const float fr = (float)(rev - __builtin_rint(rev));
          cs[i] = (f32x2){__builtin_amdgcn_cosf(fr), __builtin_amdgcn_sinf(fr)}; } }
    { float* bp = (float*)(ws + WS_BINP); for (int i = gt; i < INC; i += NGT) bp[i] = a.b_in[src_in(i)];
      float* b1p = (float*)(ws + WS_B1P); for (int i = gt; i < NE * 2048; i += NGT) { const int e = i >> 11, n = i & 2047; b1p[i] = a.b1[(size_t)e * 2048 + src_w1(n)]; } }
}

__device__ __forceinline__ void ln1_router_phase(Frame& F, const Args& a) {
    F.lane = lane_now();
    unsigned char* ws = a.ws;
    LAS float* WrT = (LAS float*)F.lds;
    LAS int* hist = (LAS int*)(F.lds + 32 * 1028 * 4);
    LAS int* gbase = hist + 32;
    LAS int* rinfo = gbase + 32;
    const bf16_t* Y1 = (const bf16_t*)(ws + WS_Y1); bf16_t* X1 = (bf16_t*)(ws + WS_X1); unsigned char* X1Q = (unsigned char*)(ws + WS_X1B);
    int* topi = (int*)(ws + WS_TOPI); float* topw = (float*)(ws + WS_TOPW); int* trank = (int*)(ws + WS_RANK); int* list = (int*)(ws + WS_LIST);
    unsigned* gcount = F.ctl + CW_GCOUNT;
    for (int idx = F.tid; idx < DM * NE; idx += NTHR) { const int col = idx >> 5, e = idx & 31; WrT[e * 1028 + col] = a.wr[idx]; }
    f32x4 gv[4], bv[4];
#pragma unroll
    for (int j = 0; j < 4; ++j) { gv[j] = *(const f32x4*)(a.ln1g + 4 * F.lane + 256 * j); bv[j] = *(const f32x4*)(a.ln1b + 4 * F.lane + 256 * j); }
    const int myexp = F.lane >> 1;
    const float mybr = a.br[myexp];
    __syncthreads();
    for (int chunk = blockIdx.x; chunk < T / 128; chunk += F.G) {
        if (F.tid < 32) hist[F.tid] = 0;
        __syncthreads();
        for (int rr = 0; rr < 8; ++rr) {
            f32x4 v[2][4];
#pragma unroll
            for (int q = 0; q < 2; ++q) {
                const int t = chunk * 128 + F.wave * 16 + rr + 8 * q; float s = 0.f;
#pragma unroll
                for (int j = 0; j < 4; ++j) { const u32x2 mm = *(const u32x2*)(Y1 + (size_t)t * DM + 4 * F.lane + 256 * j); const f32x4 xx = *(const f32x4*)(a.x + (size_t)t * DM + 4 * F.lane + 256 * j);
                    v[q][j] = xx * ALPHA + (f32x4){bflo(mm.x), bfhi(mm.x), bflo(mm.y), bfhi(mm.y)}; s += (v[q][j][0] + v[q][j][1]) + (v[q][j][2] + v[q][j][3]); }
                const float mean = wave_sum(s) * (1.f / DM); float s2 = 0.f;
#pragma unroll
                for (int j = 0; j < 4; ++j) { v[q][j] = v[q][j] - mean; s2 += (v[q][j][0] * v[q][j][0] + v[q][j][1] * v[q][j][1]) + (v[q][j][2] * v[q][j][2] + v[q][j][3] * v[q][j][3]); }
                const float rstd = 1.f / sqrtf(wave_sum(s2) * (1.f / DM) + LN_EPS);
#pragma unroll
                for (int j = 0; j < 4; ++j) { v[q][j] = v[q][j] * rstd * gv[j] + bv[j];
                    { u32x2 wb; wb.x = pk2(v[q][j][0], v[q][j][1]); wb.y = pk2(v[q][j][2], v[q][j][3]); *(u32x2*)(X1 + (size_t)t * DM + 4 * F.lane + 256 * j) = wb; }
                    *(unsigned*)(X1Q + (size_t)t * DM + 4 * F.lane + 256 * j) = pk4_fp8(v[q][j][0] * XSCALE, v[q][j][1] * XSCALE, v[q][j][2] * XSCALE, v[q][j][3] * XSCALE); }
            }
            f32x2 vp[4][4];
#pragma unroll
            for (int j = 0; j < 4; ++j)
#pragma unroll
                for (int c = 0; c < 4; ++c) vp[j][c] = (f32x2){v[0][j][c], v[1][j][c]};
            float acc[2][32];
#pragma unroll
            for (int e = 0; e < 32; ++e) { f32x2 sa = {0.f, 0.f}, sb = {0.f, 0.f};
#pragma unroll
                for (int j = 0; j < 4; ++j) { const f32x4 w = *(const LAS f32x4*)(WrT + e * 1028 + 4 * F.lane + 256 * j);
                    sa = __builtin_elementwise_fma(vp[j][0], (f32x2){w[0], w[0]}, sa); sb = __builtin_elementwise_fma(vp[j][1], (f32x2){w[1], w[1]}, sb);
                    sa = __builtin_elementwise_fma(vp[j][2], (f32x2){w[2], w[2]}, sa); sb = __builtin_elementwise_fma(vp[j][3], (f32x2){w[3], w[3]}, sb); }
                const f32x2 st = sa + sb; acc[0][e] = st[0]; acc[1][e] = st[1]; }
#pragma unroll
            for (int q = 0; q < 2; ++q) {
                const int rl_ = F.wave * 16 + rr + 8 * q, t = chunk * 128 + rl_;
#define RS_STEP(NV, MASK) _Pragma("unroll") for (int i = 0; i < (NV); ++i) { const bool up = (F.lane & (MASK)) != 0; const float send = up ? acc[q][i] : acc[q][i + (NV)]; const float keep = up ? acc[q][i + (NV)] : acc[q][i]; acc[q][i] = keep + __shfl_xor(send, (MASK)); }
                RS_STEP(16, 32) RS_STEP(8, 16) RS_STEP(4, 8) RS_STEP(2, 4) RS_STEP(1, 2)
#undef RS_STEP
                float val = acc[q][0] + __shfl_xor(acc[q][0], 1) + mybr;
                float tv[4]; int te[4];
#pragma unroll
                for (int k = 0; k < 4; ++k) { const float mx = wave_max(val); const unsigned long long msk = __ballot(val == mx); const int sel = __builtin_ctzll(msk) >> 1; tv[k] = mx; te[k] = sel; if (myexp == sel) val = -INFINITY; }
                const float e1 = __expf(tv[1] - tv[0]), e2 = __expf(tv[2] - tv[0]), e3 = __expf(tv[3] - tv[0]); const float rs_ = 1.f / (1.f + e1 + e2 + e3);
                if (F.lane < 4) { const int k = F.lane; const int e = k == 0 ? te[0] : k == 1 ? te[1] : k == 2 ? te[2] : te[3]; const float w = (k == 0 ? 1.f : k == 1 ? e1 : k == 2 ? e2 : e3) * rs_;
                    const int lr = atomicAdd((int*)&hist[e], 1); rinfo[rl_ * 4 + k] = (e << 16) | lr; topw[(size_t)t * 4 + k] = w; }
            }
        }
        __syncthreads();
        if (F.tid < 32) gbase[F.tid] = (int)__hip_atomic_fetch_add(gcount + F.tid, (unsigned)hist[F.tid], RLX_AGENT);
        __syncthreads();
        { const int info = rinfo[F.tid], e = info >> 16, rank = gbase[e] + (info & 0xffff), t = chunk * 128 + (F.tid >> 2);
          list[(size_t)e * LCAP + rank] = t * 4 + (F.tid & 3); }
        __syncthreads();
    }
}
__device__ __forceinline__ void build_tile_table(Frame& F) {
    volatile LAS int* tb = (volatile LAS int*)(F.MISC + MW_TB); volatile LAS int* cnt = (volatile LAS int*)(F.MISC + MW_CNT);
    __syncthreads();
    if (F.tid < 64) {
        const int e = F.tid & 31, c = (int)__hip_atomic_load(F.ctl + CW_GCOUNT + e, RLX_AGENT), nt_ = (c + 255) >> 8;
        int incl = nt_;
#pragma unroll
        for (int o = 1; o < 32; o <<= 1) { const int v = __shfl_up(incl, o, 32); if (e >= o) incl += v; }
        if (F.tid < 32) { cnt[e] = c; tb[e] = incl - nt_; if (e == 31) tb[NE] = incl; }
    }
    __syncthreads();
}
__device__ __forceinline__ void final_phase(Frame& F, const Args& a) {
    F.lane = lane_now();
    unsigned char* ws = a.ws;
    const LAS int* tb = (const LAS int*)(F.MISC + MW_TB);
    const bf16_t* X1 = (const bf16_t*)(ws + WS_X1); const unsigned char* Y = (const unsigned char*)(ws + WS_Y);
    const int* topi = (const int*)(ws + WS_TOPI); const float* topw = (const float*)(ws + WS_TOPW); const int* trank = (const int*)(ws + WS_RANK);
    const int gw = blockIdx.x * NWAVES + F.wave, NGW = F.G * NWAVES;
    f32x4 gv[2][2], bv[2][2];
#pragma unroll
    for (int j = 0; j < 2; ++j)
#pragma unroll
        for (int n = 0; n < 2; ++n) { gv[j][n] = *(const f32x4*)(a.ln2g + 512 * j + 8 * F.lane + 4 * n); bv[j][n] = *(const f32x4*)(a.ln2b + 512 * j + 8 * F.lane + 4 * n); }
    for (int t0 = gw; t0 < T; t0 += 2 * NGW) {
        const int tr[2] = {t0, (t0 + NGW < T) ? t0 + NGW : t0};
        f32x4 z[2][2][2]; u32x2 y[2][4][2]; float w[2][4];
#pragma unroll
        for (int q = 0; q < 2; ++q) {
            const int t = tr[q];
#pragma unroll
            for (int k = 0; k < 4; ++k) { w[q][k] = topw[(size_t)t * 4 + k]; const size_t slot = (size_t)t * 4 + k;
#pragma unroll
                for (int j = 0; j < 2; ++j) y[q][k][j] = *(const u32x2*)(Y + slot * DM + 512 * j + 8 * F.lane); w[q][k] *= (1.0f / YSCALE); }
#pragma unroll
            for (int j = 0; j < 2; ++j) { const u32x4 xx = *(const u32x4*)(X1 + (size_t)t * DM + 512 * j + 8 * F.lane);
                z[q][j][0] = (f32x4){bflo(xx.x), bfhi(xx.x), bflo(xx.y), bfhi(xx.y)} * ALPHA; z[q][j][1] = (f32x4){bflo(xx.z), bfhi(xx.z), bflo(xx.w), bfhi(xx.w)} * ALPHA; }
        }
        float s[2] = {0.f, 0.f};
#pragma unroll
        for (int q = 0; q < 2; ++q) {
#pragma unroll
            for (int k = 0; k < 4; ++k)
#pragma unroll
                for (int j = 0; j < 2; ++j) { const u32x2 yy = y[q][k][j];
                    const f32x2 a0 = __builtin_amdgcn_cvt_pk_f32_fp8((int)yy.x, false), a1 = __builtin_amdgcn_cvt_pk_f32_fp8((int)yy.x, true), a2 = __builtin_amdgcn_cvt_pk_f32_fp8((int)yy.y, false), a3 = __builtin_amdgcn_cvt_pk_f32_fp8((int)yy.y, true);
                    z[q][j][0] += (f32x4){a0[0], a0[1], a1[0], a1[1]} * w[q][k]; z[q][j][1] += (f32x4){a2[0], a2[1], a3[0], a3[1]} * w[q][k]; }
#pragma unroll
            for (int j = 0; j < 2; ++j)
#pragma unroll
                for (int n = 0; n < 2; ++n) s[q] += (z[q][j][n][0] + z[q][j][n][1]) + (z[q][j][n][2] + z[q][j][n][3]);
        }
#pragma unroll
        for (int o = 1; o < 64; o <<= 1) { s[0] += __shfl_xor(s[0], o); s[1] += __shfl_xor(s[1], o); }
        float s2[2] = {0.f, 0.f};
#pragma unroll
        for (int q = 0; q < 2; ++q) { const float mean = s[q] * (1.f / DM);
#pragma unroll
            for (int j = 0; j < 2; ++j)
#pragma unroll
                for (int n = 0; n < 2; ++n) { z[q][j][n] = z[q][j][n] - mean; s2[q] += (z[q][j][n][0] * z[q][j][n][0] + z[q][j][n][1] * z[q][j][n][1]) + (z[q][j][n][2] * z[q][j][n][2] + z[q][j][n][3] * z[q][j][n][3]); } }
#pragma unroll
        for (int o = 1; o < 64; o <<= 1) { s2[0] += __shfl_xor(s2[0], o); s2[1] += __shfl_xor(s2[1], o); }
#pragma unroll
        for (int q = 0; q < 2; ++q) { if (q == 1 && t0 + NGW >= T) break; const float rstd = 1.f / sqrtf(s2[q] * (1.f / DM) + LN_EPS);
#pragma unroll
            for (int j = 0; j < 2; ++j)
#pragma unroll
                for (int n = 0; n < 2; ++n) *(f32x4*)(a.out + (size_t)tr[q] * DM + 512 * j + 8 * F.lane + 4 * n) = z[q][j][n] * rstd * gv[j][n] + bv[j][n]; }
    }
}

constexpr int NPHASE = 9;
__global__ void __launch_bounds__(NTHR, 2) hybrid_fwd(Args a) {
    extern __shared__ __attribute__((aligned(16))) unsigned char lds_raw[];
    Frame F;
    F.lds = (LAS unsigned char*)lds_raw; F.MISC = (volatile LAS unsigned*)(F.lds + MISC_OFF);
    F.tid = threadIdx.x; F.lane = lane_now(); F.wave = __builtin_amdgcn_readfirstlane(F.tid >> 6); F.G = gridDim.x;
    unsigned char* ws = a.ws; F.ctl = (unsigned*)(ws + WS_CTL);
    for (int u = F.tid; u < 256; u += NTHR) F.MISC[u] = 0u;
    __syncthreads();
    const int lo = a.ph_lo, hi = a.ph_hi;
    XcdBarrier bar; bar.bar = F.ctl + CW_BAR; bar.x = 0; bar.st = nullptr;
    if (hi - lo > 1) bar = xcd_barrier_post(F.ctl + CW_BAR, F.MISC + MW_BAR);
#define IN(k) (lo <= (k) && (k) < hi)
#define SEAM(k) do { if (IN(k) && IN((k) + 1)) xcd_barrier(bar); } while (0)
#ifndef REP_PH
#define REP_PH -1
#endif
#define NREP(k) (((k) == REP_PH) ? 2 : 1)
#define REPEAT(k) for (int rep_ = 0; rep_ < NREP(k); ++rep_, (rep_ < NREP(k) ? xcd_barrier(bar) : (void)0))
    if (F.wave == 0) { const float p1 = a.lq1[F.lane] * a.lk1[F.lane], p2 = a.lq2[F.lane] * a.lk2[F.lane];
        const float s1 = wave_sum(p1), s2 = wave_sum(p2); if (F.lane == 0) ((volatile LAS float*)F.MISC)[MW_LAM] = __expf(s1) - __expf(s2) + LAM_INIT; }
    __syncthreads();
    const float lam = ((volatile LAS float*)F.MISC)[MW_LAM];

    if (IN(0)) REPEAT(0) { p0_prologue(F, a); } SEAM(0);
    if (IN(1)) REPEAT(1) {
        pg8::DenseOrderOff S; S.init(T, INC, DM / 2, F.G, (int)blockIdx.x, ws + WS_XB, ws + WS_WIN); S.rowb = DM;
        pg8::EpiInProj E{(bf16_t*)(ws + WS_QKV), (bf16_t*)(ws + WS_G), (const float*)(ws + WS_BINP), (const f32x2*)(ws + WS_CS), F.ctl + CW_KMAX, F.lds};
        pg8::gemm_phase<pg8::EpiInProj, pg8::DenseOrderOff, true, true, WS_E8, XIN_E8>(F.lds, DM / 2, S, E);
    } SEAM(1);
    if (IN(2)) {
        const da::bf16* Qd = (const da::bf16*)(ws + WS_QKV); const da::bf16* Kd = Qd + (size_t)T * 512; const da::bf16* Vd = Kd + (size_t)T * 512;
        bf16_t* Ad = (bf16_t*)(ws + WS_ADA);
        const int nun = NBATCH * 4 * (SEQ / da::UROWS);
        const int cslot = MOE_IN_P2 ? (int)((F.G == 256 ? (blockIdx.x >> 3) : blockIdx.x) % 6) : -1;
        bool cdone = !MOE_IN_P2;
        constexpr int MW_KM = 208;
        if (F.G == 256) {
            if (F.tid < 24) { const int w = F.tid & 3, sl = F.tid >> 2; unsigned v;
                if (sl < 2) { const int bh = (blockIdx.x & 7) + 8 * sl; v = __hip_atomic_load(F.ctl + CW_KMAX + (bh >> 2) * 16 + (bh & 3) * 4 + w, RLX_AGENT); }
                else { const int u = (blockIdx.x & 7) * 128 + (blockIdx.x >> 3) * 4 + (sl - 2); v = __hip_atomic_load(F.ctl + CW_KMAX + 64 + (u >> 8) * 16 + (u & 3) * 4 + w, RLX_AGENT); }
                F.MISC[MW_KM + F.tid] = v; }
            __syncthreads();
        }
        REPEAT(20) for (int i = 0;; ++i) {
            int bh, qb;
            if (F.G == 256) { if (i >= 4) break; const int xcd = blockIdx.x & 7, loc = blockIdx.x >> 3; bh = xcd + 8 * (i >> 1); qb = loc + 32 * (i & 1); }
            else { const int u = i * F.G + blockIdx.x; if (u >= nun) break; bh = u >> 6; qb = u & 63; }
            if (!cdone && i == cslot) { __syncthreads(); p0_moe(F, a); __syncthreads(); cdone = true; }
            const int b = bh >> 2, h = bh & 3; const size_t row0 = (size_t)b * SEQ;
            int kms = MW_KM + 4 * (i >> 1);
            if (F.G != 256) { __syncthreads(); if (F.tid < 4) F.MISC[MW_KM + F.tid] = __hip_atomic_load(F.ctl + CW_KMAX + b * 16 + h * 4 + F.tid, RLX_AGENT); __syncthreads(); kms = MW_KM; }
            da::attn_unit2<0>(Qd + (row0 + (size_t)qb * da::UROWS) * 512 + h * 128, Kd + row0 * 512 + h * 128, Vd + row0 * 512 + h * 128,
                             Ad + (row0 + (size_t)qb * da::UROWS) * da::OLD + h * 128, lam, a.subg, SEQ / da::KVBLK, (char*)lds_raw, 0, 0, 0, (const float*)(F.ctl + CW_KMAX) + b * 16 + h * 4, F.MISC + kms);
        }
        if (!cdone && cslot <= 4) { __syncthreads(); p0_moe(F, a); __syncthreads(); cdone = true; }
        REPEAT(21) {
            float* bias8 = (float*)((char*)lds_raw + da::L2_BIAS);
            float bmx = 0.f;
            for (int i = F.tid; i < 8 * 465; i += NTHR) { const float v = a.rpb[i] * 1.4426950408889634f; bias8[i] = v; bmx = fmaxf(bmx, fabsf(v)); }
            bmx = wave_max(bmx); if ((F.tid & 63) == 0) ((volatile LAS float*)F.MISC)[200 + F.wave] = bmx;
            __syncthreads();
            float bmax = 0.f;
#pragma unroll
            for (int w8 = 0; w8 < 8; ++w8) bmax = fmaxf(bmax, ((volatile LAS float*)F.MISC)[200 + w8]);
            const da::bf16* Qn = Qd + 3 * (size_t)T * 512; const da::bf16* Kn = Qn + (size_t)T * 512; const da::bf16* Vn = Kn + (size_t)T * 512;
            bf16_t* An = (bf16_t*)(ws + WS_ADA) + 512;
            for (int i = 0;; ++i) {
                int u;
                if (F.G == 256) { if (i >= 4) break; u = (blockIdx.x & 7) * 128 + (blockIdx.x >> 3) * 4 + i; } else { u = i * F.G + blockIdx.x; if (u >= 1024) break; }
                const int hp = u & 3, rp = (u >> 2) & 63, b = u >> 8, r0 = rp * 2, R0 = min(max(r0 - 4, 0), 120);
                const size_t row0 = (size_t)b * SEQ;
                int kms = MW_KM + 8 + 4 * i;
                if (F.G != 256) { __syncthreads(); if (F.tid < 4) F.MISC[MW_KM + F.tid] = __hip_atomic_load(F.ctl + CW_KMAX + 64 + b * 16 + hp * 4 + F.tid, RLX_AGENT); __syncthreads(); kms = MW_KM; }
                da::attn_unit2<1>(Qn + (row0 + (size_t)r0 * 64) * 512 + hp * 128, Kn + row0 * 512 + hp * 128, Vn + row0 * 512 + hp * 128,
                                 An + (row0 + (size_t)r0 * 64) * da::OLD + hp * 128, bmax, (const float*)(F.ctl + CW_KMAX) + 64 + b * 16 + hp * 4, 9, (char*)lds_raw, r0, R0, hp, bias8, F.MISC + kms);
            }
        }
        if (!cdone) { __syncthreads(); p0_moe(F, a); }
    } SEAM(2);
    if (IN(3)) REPEAT(3) {
        pg8::DenseOrder S; S.init(T, DM, DM, F.G, (int)blockIdx.x, ws + WS_ADA, ws + WS_WDA);
        pg8::EpiGate2 E{(bf16_t*)(ws + WS_MERGED), (const bf16_t*)(ws + WS_G)};
        pg8::gemm_phase<pg8::EpiGate2, pg8::DenseOrder, false>(F.lds, DM, S, E);
    } SEAM(3);
    if (IN(4)) REPEAT(4) {
        pg8::DenseOrder S; S.init(T, DM, DM, F.G, (int)blockIdx.x, ws + WS_MERGED, ws + WS_WOUT);
        pg8::EpiResF32 E{(bf16_t*)(ws + WS_Y1)};
        pg8::gemm_phase<pg8::EpiResF32, pg8::DenseOrder, false>(F.lds, DM, S, E);
    } SEAM(4);
    if (IN(5)) { ln1_router_phase(F, a); } SEAM(5);
    if (IN(6)) REPEAT(6) {
        build_tile_table(F);
        pg8::GroupedOrder<true> S{(const LAS int*)(F.MISC + MW_TB), (const LAS int*)(F.MISC + MW_CNT), 8, F.G, (int)blockIdx.x, DM / 2, (const char*)(ws + WS_X1B), (const char*)(ws + WS_W1),
                                  0, (size_t)256 * DM, (size_t)2048 * DM, (const int*)(ws + WS_LIST)};
        pg8::EpiSwiglu E{(unsigned char*)(ws + WS_H), (const float*)(ws + WS_B1P), F.lds};
        pg8::gemm_phase<pg8::EpiSwiglu, pg8::GroupedOrder<true>, true, true, WS_E8, XS_E8>(F.lds, DM / 2, S, E);
    } SEAM(6);
    if (IN(7)) REPEAT(7) {
        build_tile_table(F);
        pg8::GroupedOrder<false> S{(const LAS int*)(F.MISC + MW_TB), (const LAS int*)(F.MISC + MW_CNT), 4, F.G, (int)blockIdx.x, DM / 2, (const char*)(ws + WS_H), (const char*)(ws + WS_W2),
                                   (size_t)256 * DM, (size_t)256 * DM, (size_t)DM * DM, nullptr};
        pg8::EpiDown E{(unsigned char*)(ws + WS_Y), a.b2, (const int*)(ws + WS_LIST), F.lds};
        pg8::gemm_phase<pg8::EpiDown, pg8::GroupedOrder<false>, true, true, WS_E8, HS_E8>(F.lds, DM / 2, S, E);
    } SEAM(7);
    if (IN(8)) REPEAT(8) { final_phase(F, a); }
#undef IN
#undef SEAM
}

extern "C" void kernel_launch(void* const* d_in, const int* in_sizes, int n_in, void* d_out, int out_size, void* d_ws, size_t ws_size, hipStream_t stream) {
    static int grid = 0;
    if (grid == 0) {
        if (n_in != 22 || in_sizes[0] != T * DM || out_size != T * DM || ws_size < WS_END) { fprintf(stderr, "kernel_launch: shape / workspace mismatch (n_in %d, ws %zu)\n", n_in, ws_size); grid = -1; return; }
        int dev = 0, cus = 0, per_cu = 0;
        if (hipGetDevice(&dev) != hipSuccess || hipDeviceGetAttribute(&cus, hipDeviceAttributeMultiprocessorCount, dev) != hipSuccess) { grid = -1; return; }
        if (hipFuncSetAttribute((const void*)hybrid_fwd, hipFuncAttributeMaxDynamicSharedMemorySize, LDS_BYTES) != hipSuccess) { fprintf(stderr, "kernel_launch: hipFuncSetAttribute failed\n"); grid = -1; return; }
        if (hipOccupancyMaxActiveBlocksPerMultiprocessor(&per_cu, (const void*)hybrid_fwd, NTHR, LDS_BYTES) != hipSuccess || per_cu < 1) { fprintf(stderr, "kernel_launch: occupancy query says %d\n", per_cu); }
        (void)hipGetLastError();
        grid = cus;
    }
    if (grid < 0) return;
    (void)hipMemsetAsync((char*)d_ws + WS_CTL, 0, CTL_ZERO_BYTES, stream);
    Args a{};
    const float** p = (const float**)&a;
    for (int i = 0; i < 22; ++i) p[i] = (const float*)d_in[i];
    a.out = (float*)d_out; a.ws = (unsigned char*)d_ws;
#if MK_SPLIT
    for (int ph = 0; ph < NPHASE; ++ph) { a.ph_lo = ph; a.ph_hi = ph + 1; hipLaunchKernelGGL(hybrid_fwd, dim3(grid), dim3(NTHR), LDS_BYTES, stream, a); }
#else
    a.ph_lo = 0; a.ph_hi = NPHASE; hipLaunchKernelGGL(hybrid_fwd, dim3(grid), dim3(NTHR), LDS_BYTES, stream, a);
#endif
    const hipError_t le = hipPeekAtLastError();
    if (le != hipSuccess) fprintf(stderr, "kernel_launch: launch failed: %s\n", hipGetErrorName(le));
}
```

```cpp
#include <hip/hip_runtime.h>
#include <hip/hip_bf16.h>
#include <cstdio>
#include <cstdint>

#ifndef MK_SPLIT
#define MK_SPLIT 0
#endif

#define LAS __attribute__((address_space(3)))
#define GAS __attribute__((address_space(1)))
typedef unsigned short bf16_t;
typedef short bf16x8 __attribute__((ext_vector_type(8)));
typedef short s16x4 __attribute__((ext_vector_type(4)));
typedef float f32x2 __attribute__((ext_vector_type(2)));
typedef float f32x4 __attribute__((ext_vector_type(4)));
typedef float f32x16 __attribute__((ext_vector_type(16)));
typedef unsigned u32x2 __attribute__((ext_vector_type(2)));
typedef unsigned u32x4 __attribute__((ext_vector_type(4)));
typedef __bf16 bf16x2_t __attribute__((ext_vector_type(2)));
typedef int v4i_t __attribute__((ext_vector_type(4)));
typedef int v8i_t __attribute__((ext_vector_type(8)));

constexpr int DM = 1024, NBATCH = 4, SEQ = 8192, T = NBATCH * SEQ, INC = 5120;
constexpr int NE = 32, TOPK = 4, TK = T * TOPK, MAXTILES = TK / 256 + NE, PROWS = MAXTILES * 256, LCAP = T;
constexpr float LN_EPS = 1e-5f, RMS_EPS = 1e-5f;
constexpr float ALPHA = 1.189207115002721f;
constexpr float LAM_INIT = 0.2f;
constexpr float QSCALE = 0.125f * 1.4426950408889634f;
constexpr int NWAVES = 8, NTHR = 512;
constexpr float YSCALE = 16.f;
constexpr float XINSCALE = 16.f; constexpr int XIN_E8 = 127 - 4;
constexpr float ASCALE = 16.f; constexpr int A_E8 = 127 - 4;
constexpr float MSCALE = 16.f; constexpr int M_E8 = 127 - 4;
constexpr float WSCALE = 64.f, XSCALE = 8.f, HSCALE = 4.f; constexpr int WS_E8 = 127 - 6, XS_E8 = 127 - 3, HS_E8 = 127 - 2;

constexpr size_t MiB = 1u << 20;
constexpr size_t WS_CTL = 0, CTL_ZERO_BYTES = 32768;
constexpr size_t WS_CS = 1 * MiB;
constexpr size_t WS_BINP = 3 * MiB;
constexpr size_t WS_B1P = 3 * MiB + 65536;
constexpr size_t WS_TOPI = 4 * MiB, WS_TOPW = 4 * MiB + 524288, WS_RANK = 5 * MiB;
constexpr size_t WS_LIST = 6 * MiB;
constexpr size_t WS_WIN = 16 * MiB, WS_WDA = 26 * MiB, WS_WNA = 27 * MiB, WS_WOUT = 28 * MiB;
constexpr size_t WS_W1 = 32 * MiB, WS_W2 = 160 * MiB;
constexpr size_t WS_XB = 224 * MiB;
constexpr size_t WS_QKV = 288 * MiB;
constexpr size_t WS_G = 480 * MiB;
constexpr size_t WS_Y1 = 288 * MiB;
constexpr size_t WS_X1B = 544 * MiB;
constexpr size_t WS_H = 224 * MiB;
constexpr size_t WS_ADA = 608 * MiB, WS_ANA = 640 * MiB;
constexpr size_t WS_MERGED = 672 * MiB;
constexpr size_t WS_Y = 608 * MiB;
constexpr size_t WS_X1 = 880 * MiB;
constexpr size_t WS_END = 1008 * MiB;
static_assert(WS_H + (size_t)PROWS * 1024 * 2 <= WS_X1B && WS_Y + (size_t)PROWS * 1024 * 2 <= WS_X1, "ws map");
constexpr int CW_TMO = 0, CW_GCOUNT = 64, CW_KMAX = 128, CW_BAR = 4096;

constexpr int RING_BYTES = 131072;
constexpr int LDS_BYTES = 147456;
constexpr int MISC_OFF = LDS_BYTES - 1024;
constexpr int MW_BAR = 0, MW_LAM = 8, MW_TB = 16, MW_CNT = 96;

#define LDS_WAIT() asm volatile("s_waitcnt lgkmcnt(0)" ::: "memory")
#define VM_WAIT() asm volatile("s_waitcnt vmcnt(0)" ::: "memory")
#define RLX_AGENT __ATOMIC_RELAXED, __HIP_MEMORY_SCOPE_AGENT

__device__ __forceinline__ unsigned pk2(float lo, float hi) { f32x2 v = {lo, hi}; bf16x2_t b = __builtin_convertvector(v, bf16x2_t); return __builtin_bit_cast(unsigned, b); }
__device__ __forceinline__ unsigned pk4_fp8(float a, float b, float c, float d) { int w = 0; w = __builtin_amdgcn_cvt_pk_fp8_f32(a, b, w, false); w = __builtin_amdgcn_cvt_pk_fp8_f32(c, d, w, true); return (unsigned)w; }
__device__ __forceinline__ float bflo(unsigned w) { return __uint_as_float(w << 16); }
__device__ __forceinline__ float bfhi(unsigned w) { return __uint_as_float(w & 0xffff0000u); }
__device__ __forceinline__ float wave_sum(float v) {
#pragma unroll
    for (int o = 1; o < 64; o <<= 1) v += __shfl_xor(v, o);
    return v;
}
__device__ __forceinline__ float wave_max(float v) {
#pragma unroll
    for (int o = 1; o < 64; o <<= 1) v = fmaxf(v, __shfl_xor(v, o));
    return v;
}
__device__ __forceinline__ float sigmoidf_(float x) { return __builtin_amdgcn_rcpf(1.f + __builtin_amdgcn_exp2f(-1.4426950408889634f * x)); }

namespace pg8 {
constexpr int BM = 256, BK = 64, HALF = 128, HTB = HALF * BK * 2, STAGE_BYTES = 8 * HTB, NXCD = 8, WGM = 8;
__host__ __device__ __forceinline__ int lds_byte(int r, int c) { const int st = (r >> 4) * 2 + (c >> 5), rr = r & 15, cc = c & 31, ob = rr * 64 + cc * 2; return st * 1024 + (ob ^ (((ob >> 9) & 1) << 5)); }
__host__ __device__ __forceinline__ void stage_rc(int b, int& R, int& C) { const int st = b / 1024, sb = b % 1024, swz = sb ^ (((sb >> 9) & 1) << 5); R = (st >> 1) * 16 + swz / 64; C = (st & 1) * 32 + (swz % 64) / 2; }
__host__ __device__ __forceinline__ int perm32(int rho) { const int n = rho >> 4, i = rho & 15; return 8 * (i >> 2) + 4 * n + (i & 3); }

struct Unit { int pm, pn, e, nv, lbase, par; };

struct DenseOrder {
    static constexpr bool LIST_LDS = false;
    int nM, nN, nwg, G, c; const char* A; const char* Bt; size_t tstep;
    __device__ void init(int M, int N, int K, int G_, int c_, const void* A_, const void* Bt_) { nM = M / BM; nN = N / BM; nwg = nM * nN; G = G_; c = c_; A = (const char*)A_; Bt = (const char*)Bt_; tstep = (size_t)BM * K * 2; }
    __device__ __forceinline__ bool next(int i, Unit& u) const {
        const long L = (long)i * G + c; if (L >= nwg) return false;
        int wgid = (int)L; { const int q = nwg / NXCD, r = nwg % NXCD, xcd = wgid % NXCD, off = wgid / NXCD; wgid = (xcd < r ? xcd * (q + 1) : r * (q + 1) + (xcd - r) * q) + off; }
        const int nig = WGM * nN, gid = wgid / nig, fm = gid * WGM, gsz = (nM - fm) < WGM ? (nM - fm) : WGM;
        u.pm = fm + ((wgid % nig) % gsz); u.pn = (wgid % nig) / gsz; u.e = 0; u.nv = 256; u.lbase = 0; return true;
    }
    __device__ __forceinline__ const char* a_ptr(const Unit& u) const { return A + (size_t)u.pm * tstep; }
    __device__ __forceinline__ const char* b_ptr(const Unit& u) const { return Bt + (size_t)u.pn * tstep; }
    __device__ __forceinline__ void a_offs(const Unit&, const int (&)[2], const int (&)[2], unsigned (&)[2][2]) const {}
};
struct DenseOrderOff : DenseOrder {
    int rowb;
    __device__ __forceinline__ const char* a_ptr(const Unit&) const { return A; }
    __device__ __forceinline__ void a_offs(const Unit& u, const int (&Rr)[2], const int (&Cc)[2], unsigned (&vo)[2][2]) const {
#pragma unroll
        for (int h = 0; h < 2; ++h)
#pragma unroll
            for (int i = 0; i < 2; ++i) vo[h][i] = (unsigned)(u.pm * BM + h * HALF + Rr[i]) * (unsigned)rowb + (unsigned)Cc[i] * 2u;
    }
};
template <bool GATHER> struct GroupedOrder {
    const LAS int* tb; const LAS int* cnt; int npn, G, c, K; const char* A; const char* Bt; size_t tstepA, tstepB, estride; const int* list;
    mutable int e0 = 0;
    __device__ __forceinline__ bool next(int i, Unit& u) const {
        const int L = i * G + c; const int total = tb[NE] * npn; if (L >= total) return false;
        int e = e0; while (e < NE - 1 && tb[e + 1] * npn <= L) ++e;
        e = __builtin_amdgcn_readfirstlane(e); e0 = e;
        const int t0 = tb[e], nte = tb[e + 1] - t0, rem = L - t0 * npn, pn = rem / nte, it = rem - pn * nte;
        u.pm = __builtin_amdgcn_readfirstlane(t0 + it); u.pn = __builtin_amdgcn_readfirstlane(pn); u.e = e;
        int nv = cnt[e] - it * 256; nv = nv > 256 ? 256 : nv; u.nv = __builtin_amdgcn_readfirstlane(nv); u.lbase = __builtin_amdgcn_readfirstlane(e * LCAP + it * 256); return true;
    }
    static constexpr bool LIST_LDS = GATHER;
    static constexpr int LIST_OFF = STAGE_BYTES + 4096;
    __device__ __forceinline__ void list_dma(LAS unsigned char* l, const Unit& u, int par, int wid) const {
        if (wid == 3) { int lane; asm volatile("v_mbcnt_lo_u32_b32 %0, -1, 0\n\tv_mbcnt_hi_u32_b32 %0, -1, %0" : "=v"(lane));
            __builtin_amdgcn_global_load_lds((const unsigned*)(list + u.lbase + lane * 4), (LAS unsigned*)(l + LIST_OFF + par * 1024), 16, 0, 0); }
    }
    __device__ __forceinline__ void a_offs_lds(const LAS unsigned char* l, const Unit& u, int par, const int (&Rr)[2], const int (&Cc)[2], unsigned (&vo)[2][2]) const {
        const LAS int* ll = (const LAS int*)(l + LIST_OFF + par * 1024);
#pragma unroll
        for (int h = 0; h < 2; ++h)
#pragma unroll
            for (int i = 0; i < 2; ++i) { const int row = h * HALF + Rr[i]; const int v = ll[row]; const int tok = row < u.nv ? (v >> 2) : 0;
                vo[h][i] = (unsigned)tok * (unsigned)(K * 2) + (unsigned)Cc[i] * 2u; }
    }
    __device__ __forceinline__ const char* a_ptr(const Unit& u) const { return A; }
    __device__ __forceinline__ const char* b_ptr(const Unit& u) const { return Bt + (size_t)u.e * estride + (size_t)u.pn * tstepB; }
    __device__ __forceinline__ void a_offs(const Unit& u, const int (&Rr)[2], const int (&Cc)[2], unsigned (&vo)[2][2]) const {
#pragma unroll
        for (int h = 0; h < 2; ++h)
#pragma unroll
            for (int i = 0; i < 2; ++i) { const int row = h * HALF + Rr[i]; int tok = u.pm * BM + row; if constexpr (GATHER) { tok = 0; if (row < u.nv) tok = list[u.lbase + row] >> 2; }
                vo[h][i] = (unsigned)tok * (unsigned)(K * 2) + (unsigned)Cc[i] * 2u; }
    }
};

template <class Epi, class Sched, bool GATHER, bool FP8 = false, int sw = 127, int sx = 127>
__device__ __forceinline__ void gemm_phase(LAS unsigned char* lds, const int K, const Sched& S, const Epi& E) {
    const int tid = threadIdx.x, wid = __builtin_amdgcn_readfirstlane(tid >> 6), lane = tid & 63, wr = wid >> 2, wc = wid & 3, fr = lane & 15, fq = lane >> 4;
    const int nt = K / BK;
    unsigned voffB[2], voA[2][2], voN[2][2]; int Rr[2], Cc[2];
    const unsigned hstepu = (unsigned)HALF * (unsigned)K * 2u;
#pragma unroll
    for (int i = 0; i < 2; ++i) { int R, C; stage_rc(tid * 16 + i * 8192, R, C); const int Rb = Epi::PERM ? ((R & ~31) + perm32(R & 31)) : R;
        voffB[i] = (unsigned)(Rb * K + C) * 2u; Rr[i] = R; Cc[i] = C;
        voA[0][i] = (unsigned)(R * K + C) * 2u; voA[1][i] = voA[0][i] + hstepu; voN[0][i] = voA[0][i]; voN[1][i] = voA[1][i]; }
    const size_t kstep = (size_t)(BK * 2);
    const size_t hstep = (size_t)HALF * K * 2;
    const unsigned ldsw = (unsigned)wid * 1024u;
    const int aoff = lds_byte(wr * 64 + fr, fq * 8), boff = lds_byte(wc * 32 + fr, fq * 8);
#define PG8_SA(b, h) (((b) * 2 + (h)) * HTB)
#define PG8_SB(b, h) ((4 + (b) * 2 + (h)) * HTB)
    const __amdgpu_buffer_rsrc_t rsA_ = __builtin_amdgcn_make_buffer_rsrc((void*)S.A, (short)0, 0x7FFFFFF0, 0x00020000);
    const __amdgpu_buffer_rsrc_t rsB_ = __builtin_amdgcn_make_buffer_rsrc((void*)S.Bt, (short)0, 0x7FFFFFF0, 0x00020000);
#define PG8_STAGEB(bufoff, gbase) do { const int so_ = (int)(unsigned)((const char*)(gbase) - S.Bt); _Pragma("unroll") for (int _i = 0; _i < 2; ++_i) \
        __builtin_amdgcn_raw_ptr_buffer_load_lds(rsB_, (LAS void*)(lds + (bufoff) + ldsw + _i * 8192), 16, (int)voffB[_i], so_, 0, 0); } while (0)
#define PG8_STAGEA(bufoff, gbase, h) do { const int so_ = (int)(unsigned)((const char*)(gbase) - S.A); _Pragma("unroll") for (int _i = 0; _i < 2; ++_i) \
        __builtin_amdgcn_raw_ptr_buffer_load_lds(rsA_, (LAS void*)(lds + (bufoff) + ldsw + _i * 8192), 16, (int)voA[h][_i], so_, 0, 0); } while (0)
#define PG8_LDA(dst, b, h) do { _Pragma("unroll") for (int m = 0; m < 4; ++m) _Pragma("unroll") for (int k = 0; k < 2; ++k) dst[m][k] = *(const LAS bf16x8*)(lds + PG8_SA(b, h) + aoff + m * 2048 + k * 1024); } while (0)
#define PG8_LDB(dst, b, h) do { _Pragma("unroll") for (int n = 0; n < 2; ++n) _Pragma("unroll") for (int k = 0; k < 2; ++k) dst[n][k] = *(const LAS bf16x8*)(lds + PG8_SB(b, h) + boff + n * 2048 + k * 1024); } while (0)
#define PG8_V8(x) __builtin_shufflevector(__builtin_bit_cast(v4i_t, x[0]), __builtin_bit_cast(v4i_t, x[1]), 0, 1, 2, 3, 4, 5, 6, 7)
#define PG8_MMA(ai, bj, At, Bt) do { __builtin_amdgcn_s_setprio(1); if constexpr (FP8) { _Pragma("unroll") for (int m = 0; m < 4; ++m) _Pragma("unroll") for (int n = 0; n < 2; ++n) \
        acc[ai][bj][m][n] = __builtin_amdgcn_mfma_scale_f32_16x16x128_f8f6f4(PG8_V8(Bt[n]), PG8_V8(At[m]), acc[ai][bj][m][n], 0, 0, 0, sw, 0, sx); } else { \
        _Pragma("unroll") for (int m = 0; m < 4; ++m) _Pragma("unroll") for (int n = 0; n < 2; ++n) _Pragma("unroll") for (int k = 0; k < 2; ++k) \
        acc[ai][bj][m][n] = __builtin_amdgcn_mfma_f32_16x16x32_bf16(Bt[n][k], At[m][k], acc[ai][bj][m][n], 0, 0, 0); } __builtin_amdgcn_s_setprio(0); } while (0)
#define PG8_WAIT_V(n) asm volatile("s_waitcnt vmcnt(" #n ")" ::: "memory")
#define PG8_WAIT_L(n) asm volatile("s_waitcnt lgkmcnt(" #n ")" ::: "memory")
#define PG8_BAR __builtin_amdgcn_s_barrier()
#define PG8_SCHED __builtin_amdgcn_sched_barrier(0)
#define PG8_PIN4(v) asm volatile("" : "+v"(v[0][0]), "+v"(v[0][1]), "+v"(v[1][0]), "+v"(v[1][1]))
    Unit cur, nxt; int ui = 0;
    if (!S.next(0, cur)) return;
    cur.par = 0;
    f32x4 acc[2][2][4][2];
#pragma unroll
    for (int a = 0; a < 2; ++a)
#pragma unroll
        for (int b = 0; b < 2; ++b)
#pragma unroll
            for (int m = 0; m < 4; ++m)
#pragma unroll
                for (int n = 0; n < 2; ++n) acc[a][b][m][n] = (f32x4){0.f, 0.f, 0.f, 0.f};
    bf16x8 At[4][2], B0[2][2], B1[2][2];
    const char* cA = S.a_ptr(cur); const char* cB = S.b_ptr(cur);
    if constexpr (GATHER) { S.a_offs(cur, Rr, Cc, voA); PG8_WAIT_V(0); PG8_PIN4(voA); }
    Unit nn; bool has_nn = false;
    if constexpr (Sched::LIST_LDS) { has_nn = S.next(1, nn); if (has_nn) S.list_dma(lds, nn, 1, wid); }
    PG8_STAGEB(PG8_SB(0, 0), cB); PG8_STAGEB(PG8_SB(0, 1), cB + hstep); PG8_STAGEA(PG8_SA(0, 0), cA, 0); PG8_STAGEA(PG8_SA(0, 1), cA, 1);
    if (wr == 1) PG8_BAR;
    PG8_WAIT_V(2); PG8_BAR;
    PG8_STAGEB(PG8_SB(1, 0), cB + kstep); PG8_STAGEA(PG8_SA(1, 0), cA + kstep, 0); PG8_STAGEB(PG8_SB(1, 1), cB + hstep + kstep);
    PG8_WAIT_V(6); PG8_BAR;
    for (;;) {
        bool has_next;
        if constexpr (Sched::LIST_LDS) { has_next = has_nn; nxt = nn; } else has_next = S.next(ui + 1, nxt);
        nxt.par = (ui + 1) & 1;
        const char* nA = has_next ? S.a_ptr(nxt) : cA; const char* nB = has_next ? S.b_ptr(nxt) : cB;
        if constexpr (GATHER) {
            if (has_next) { if constexpr (Sched::LIST_LDS) S.a_offs_lds(lds, nxt, (ui + 1) & 1, Rr, Cc, voN); else S.a_offs(nxt, Rr, Cc, voN); } else {
#pragma unroll
                for (int h = 0; h < 2; ++h)
#pragma unroll
                    for (int i = 0; i < 2; ++i) voN[h][i] = voA[h][i]; }
            if constexpr (Sched::LIST_LDS) { has_nn = has_next && S.next(ui + 2, nn); if (has_nn) S.list_dma(lds, nn, ui & 1, wid); PG8_WAIT_L(0); }
            else PG8_WAIT_V(0);
            PG8_PIN4(voN);
        }
        if constexpr (Epi::HAS_PRE) { E.pre(lds, cur, wid); PG8_SCHED; }
#pragma unroll 1
        for (int t = 0; t < nt; t += 2) {
            const bool last = (t == nt - 2);
            const char* a1 = cA + (size_t)(t + 1) * kstep;
            const char* a2 = last ? nA : cA + (size_t)(t + 2) * kstep; const char* b2 = last ? nB : cB + (size_t)(t + 2) * kstep;
            const char* a3 = a2 + kstep; const char* b3 = b2 + kstep;
            PG8_LDB(B0, 0, 0); PG8_LDB(B1, 0, 1); PG8_SCHED; PG8_LDA(At, 0, 0); PG8_STAGEA(PG8_SA(1, 1), a1, 1);
            if constexpr (GATHER) { if (last) {
#pragma unroll
                for (int h = 0; h < 2; ++h)
#pragma unroll
                    for (int i = 0; i < 2; ++i) voA[h][i] = voN[h][i]; } }
            PG8_WAIT_V(8); PG8_WAIT_L(0); PG8_BAR; PG8_MMA(0, 0, At, B0); PG8_MMA(0, 1, At, B1); PG8_BAR; PG8_SCHED;
            PG8_LDA(At, 0, 1); PG8_STAGEB(PG8_SB(0, 0), b2); PG8_STAGEB(PG8_SB(0, 1), b2 + hstep); PG8_STAGEA(PG8_SA(0, 0), a2, 0);
            PG8_WAIT_V(8); PG8_WAIT_L(0); PG8_BAR; PG8_MMA(1, 0, At, B0); PG8_MMA(1, 1, At, B1); PG8_BAR; PG8_SCHED;
            PG8_LDB(B0, 1, 0); PG8_LDB(B1, 1, 1); PG8_SCHED; PG8_LDA(At, 1, 0); PG8_STAGEA(PG8_SA(0, 1), a2, 1);
            PG8_WAIT_V(8); PG8_WAIT_L(0); PG8_BAR; PG8_MMA(0, 0, At, B0); PG8_MMA(0, 1, At, B1); PG8_BAR; PG8_SCHED;
            PG8_LDA(At, 1, 1); PG8_STAGEB(PG8_SB(1, 0), b3); PG8_STAGEB(PG8_SB(1, 1), b3 + hstep); PG8_STAGEA(PG8_SA(1, 0), a3, 0);
            PG8_WAIT_V(8); PG8_WAIT_L(0); PG8_BAR; PG8_MMA(1, 0, At, B0); PG8_MMA(1, 1, At, B1); PG8_BAR; PG8_SCHED;
            if constexpr (Epi::HAS_MID) { if (t + 2 == nt / 2) { E.mid(acc, cur, wr, wc, fr, fq); PG8_SCHED; } }
        }
        if (wr == 0) PG8_BAR;
        E(acc, cur, wr, wc, fr, fq);
        if (!has_next) break;
#pragma unroll
        for (int a = 0; a < 2; ++a)
#pragma unroll
            for (int b = 0; b < 2; ++b)
#pragma unroll
                for (int m = 0; m < 4; ++m)
#pragma unroll
                    for (int n = 0; n < 2; ++n) acc[a][b][m][n] = (f32x4){0.f, 0.f, 0.f, 0.f};
        cur = nxt; cA = nA; cB = nB; ++ui;
        if (wr == 1) PG8_BAR;
    }
    PG8_WAIT_V(0);
    PG8_BAR;
#undef PG8_SA
#undef PG8_SB
#undef PG8_STAGEA
#undef PG8_STAGEB
#undef PG8_LDA
#undef PG8_LDB
#undef PG8_MMA
#undef PG8_V8
#undef PG8_WAIT_V
#undef PG8_WAIT_L
#undef PG8_BAR
#undef PG8_SCHED
#undef PG8_PIN4
}

struct EpiInProj {
    static constexpr bool PERM = true, HAS_MID = false, HAS_PRE = true;
    bf16_t* QKV; unsigned char* G; const float* binp; const f32x2* cs; unsigned* kmax; LAS unsigned char* lds;
    __device__ __forceinline__ void pre(LAS unsigned char* l, const Unit& u, int wid) const {
        if (wid == 0) { int lane; asm volatile("v_mbcnt_lo_u32_b32 %0, -1, 0\n\tv_mbcnt_hi_u32_b32 %0, -1, %0" : "=v"(lane));
            __builtin_amdgcn_global_load_lds((const unsigned*)(binp + u.pn * BM + lane * 4), (LAS unsigned*)(l + STAGE_BYTES + u.par * 2048), 16, 0, 0); }
    }
    __device__ __forceinline__ void operator()(const f32x4 (&acc)[2][2][4][2], const Unit& u, int wr, int wc, int fr, int fq) const {
        const int colt = u.pn * BM, tt = colt >> 9;
        const int cw = wc * 32 + 8 * fq;
        f32x4 bv[2][2];
#pragma unroll
        for (int bj = 0; bj < 2; ++bj)
#pragma unroll
            for (int n = 0; n < 2; ++n) bv[bj][n] = *(const LAS f32x4*)((const LAS float*)(lds + STAGE_BYTES + u.par * 2048) + bj * HALF + cw + 4 * n);
        float kmx[2] = {0.f, 0.f};
#pragma unroll
        for (int ai = 0; ai < 2; ++ai)
#pragma unroll
            for (int m = 0; m < 4; ++m) {
                const int row = u.pm * BM + ai * HALF + wr * 64 + m * 16 + fr;
#pragma unroll
                for (int bj = 0; bj < 2; ++bj) {
                    f32x4 v0 = acc[ai][bj][m][0] + bv[bj][0], v1 = acc[ai][bj][m][1] + bv[bj][1];
                    const int col = colt + bj * HALF + cw;
                    u32x4 w;
                    if (tt < 2) {
                        const int pos = row & (SEQ - 1), dp = (col & 63) >> 1;
                        const f32x4 c01 = *(const f32x4*)(cs + (size_t)pos * 32 + dp), c23 = *(const f32x4*)(cs + (size_t)pos * 32 + dp + 2);
                        const float a0 = v0[0] * c01[0] - v0[1] * c01[1], b0 = v0[1] * c01[0] + v0[0] * c01[1];
                        const float a1 = v0[2] * c01[2] - v0[3] * c01[3], b1 = v0[3] * c01[2] + v0[2] * c01[3];
                        const float a2 = v1[0] * c23[0] - v1[1] * c23[1], b2 = v1[1] * c23[0] + v1[0] * c23[1];
                        const float a3 = v1[2] * c23[2] - v1[3] * c23[3], b3 = v1[3] * c23[2] + v1[2] * c23[3];
                        if (tt == 1) { float ss = (a0 * a0 + b0 * b0) + (a1 * a1 + b1 * b1) + (a2 * a2 + b2 * b2) + (a3 * a3 + b3 * b3);
                            ss += __shfl_xor(ss, 16); ss += __shfl_xor(ss, 32);
                            kmx[bj] = fmaxf(kmx[bj], ss); }
                        const float qs = tt == 0 ? QSCALE : 1.0f;
                        w.x = pk2(a0 * qs, b0 * qs); w.y = pk2(a1 * qs, b1 * qs); w.z = pk2(a2 * qs, b2 * qs); w.w = pk2(a3 * qs, b3 * qs);
                    } else if (tt < 6) {
                        if (tt == 4) { float ss = (v0[0] * v0[0] + v0[1] * v0[1]) + (v0[2] * v0[2] + v0[3] * v0[3]) + (v1[0] * v1[0] + v1[1] * v1[1]) + (v1[2] * v1[2] + v1[3] * v1[3]);
                            ss += __shfl_xor(ss, 16); ss += __shfl_xor(ss, 32); kmx[bj] = fmaxf(kmx[bj], ss); }
                        const float qs = tt == 3 ? QSCALE : 1.0f;
                        w.x = pk2(v0[0] * qs, v0[1] * qs); w.y = pk2(v0[2] * qs, v0[3] * qs); w.z = pk2(v1[0] * qs, v1[1] * qs); w.w = pk2(v1[2] * qs, v1[3] * qs);
                    } else {
#define G8(x) fmaxf(255.f * sigmoidf_(x), 1.f)
                        unsigned lo = __builtin_amdgcn_cvt_pk_u8_f32(G8(v0[0]), 0, 0u); lo = __builtin_amdgcn_cvt_pk_u8_f32(G8(v0[1]), 1, lo); lo = __builtin_amdgcn_cvt_pk_u8_f32(G8(v0[2]), 2, lo); lo = __builtin_amdgcn_cvt_pk_u8_f32(G8(v0[3]), 3, lo);
                        unsigned hi4 = __builtin_amdgcn_cvt_pk_u8_f32(G8(v1[0]), 0, 0u); hi4 = __builtin_amdgcn_cvt_pk_u8_f32(G8(v1[1]), 1, hi4); hi4 = __builtin_amdgcn_cvt_pk_u8_f32(G8(v1[2]), 2, hi4); hi4 = __builtin_amdgcn_cvt_pk_u8_f32(G8(v1[3]), 3, hi4);
#undef G8
                        w.x = lo; w.y = hi4; w.z = 0u; w.w = 0u;
                    }
                    if (tt < 6) *(u32x4*)(QKV + (size_t)tt * ((size_t)T * 512) + (size_t)row * 512 + (col - tt * 512)) = w;
                    else { u32x2 w2; w2.x = w.x; w2.y = w.y; *(u32x2*)(G + (size_t)row * 2048 + (col - 3072)) = w2; }
                }
            }
        if (tt == 1 || tt == 4) {
#pragma unroll
            for (int bj = 0; bj < 2; ++bj) { float v = kmx[bj];
                v = fmaxf(v, __shfl_xor(v, 1)); v = fmaxf(v, __shfl_xor(v, 2)); v = fmaxf(v, __shfl_xor(v, 4)); v = fmaxf(v, __shfl_xor(v, 8));
                const int c32 = (colt - tt * 512 + bj * HALF + wc * 32) >> 5, b = (u.pm * BM) >> 13;
                if ((threadIdx.x & 63) == 0) atomicMax(kmax + (tt == 4 ? 64 : 0) + b * 16 + c32, __float_as_uint(v)); }
        }
    }
};
template <int MODE> struct EpiGate {
    static constexpr bool PERM = true, HAS_MID = false, HAS_PRE = false;
    bf16_t* M; const bf16_t* G; int goff;
    __device__ __forceinline__ void operator()(const f32x4 (&acc)[2][2][4][2], const Unit& u, int wr, int wc, int fr, int fq) const {
#pragma unroll
        for (int ai = 0; ai < 2; ++ai)
#pragma unroll
            for (int m = 0; m < 4; ++m) {
                const int row = u.pm * BM + ai * HALF + wr * 64 + m * 16 + fr;
#pragma unroll
                for (int bj = 0; bj < 2; ++bj) {
                    const int col = u.pn * BM + bj * HALF + wc * 32 + 8 * fq;
                    const u32x4 g = *(const u32x4*)(G + (size_t)row * 2048 + goff + col);
                    const f32x4 v0 = acc[ai][bj][m][0], v1 = acc[ai][bj][m][1];
                    float o[8] = {bflo(g.x) * v0[0], bfhi(g.x) * v0[1], bflo(g.y) * v0[2], bfhi(g.y) * v0[3], bflo(g.z) * v1[0], bfhi(g.z) * v1[1], bflo(g.w) * v1[2], bfhi(g.w) * v1[3]};
                    bf16_t* dst = M + (size_t)row * 1024 + col;
                    if (MODE == 1) { const u32x4 p = *(const u32x4*)dst; o[0] += bflo(p.x); o[1] += bfhi(p.x); o[2] += bflo(p.y); o[3] += bfhi(p.y); o[4] += bflo(p.z); o[5] += bfhi(p.z); o[6] += bflo(p.w); o[7] += bfhi(p.w); }
                    u32x4 w; w.x = pk2(o[0], o[1]); w.y = pk2(o[2], o[3]); w.z = pk2(o[4], o[5]); w.w = pk2(o[6], o[7]);
                    *(u32x4*)dst = w;
                }
            }
    }
};
struct EpiGate2 {
    static constexpr bool PERM = true, HAS_MID = true, HAS_PRE = false;
    bf16_t* M; const unsigned char* G;
    __device__ __forceinline__ void mid(f32x4 (&acc)[2][2][4][2], const Unit& u, int wr, int wc, int fr, int fq) const {
#pragma unroll
        for (int ai = 0; ai < 2; ++ai)
#pragma unroll
            for (int m = 0; m < 4; ++m) {
                const int row = u.pm * BM + ai * HALF + wr * 64 + m * 16 + fr;
#pragma unroll
                for (int bj = 0; bj < 2; ++bj) {
                    const int col = u.pn * BM + bj * HALF + wc * 32 + 8 * fq;
                    const u32x2 ga = *(const u32x2*)(G + (size_t)row * 2048 + col), gb = *(const u32x2*)(G + (size_t)row * 2048 + 1024 + col);
#define UB(w, i) ((float)(((w) >> (8 * (i))) & 255u))
                    const float r0 = UB(ga.x, 0) * __builtin_amdgcn_rcpf(UB(gb.x, 0)), r1 = UB(ga.x, 1) * __builtin_amdgcn_rcpf(UB(gb.x, 1));
                    const float r2 = UB(ga.x, 2) * __builtin_amdgcn_rcpf(UB(gb.x, 2)), r3 = UB(ga.x, 3) * __builtin_amdgcn_rcpf(UB(gb.x, 3));
                    const float r4 = UB(ga.y, 0) * __builtin_amdgcn_rcpf(UB(gb.y, 0)), r5 = UB(ga.y, 1) * __builtin_amdgcn_rcpf(UB(gb.y, 1));
                    const float r6 = UB(ga.y, 2) * __builtin_amdgcn_rcpf(UB(gb.y, 2)), r7 = UB(ga.y, 3) * __builtin_amdgcn_rcpf(UB(gb.y, 3));
                    acc[ai][bj][m][0] = acc[ai][bj][m][0] * (f32x4){r0, r1, r2, r3}; acc[ai][bj][m][1] = acc[ai][bj][m][1] * (f32x4){r4, r5, r6, r7};
                }
            }
    }
    __device__ __forceinline__ void operator()(const f32x4 (&acc)[2][2][4][2], const Unit& u, int wr, int wc, int fr, int fq) const {
#pragma unroll
        for (int ai = 0; ai < 2; ++ai)
#pragma unroll
            for (int m = 0; m < 4; ++m) {
                const int row = u.pm * BM + ai * HALF + wr * 64 + m * 16 + fr;
#pragma unroll
                for (int bj = 0; bj < 2; ++bj) {
                    const int col = u.pn * BM + bj * HALF + wc * 32 + 8 * fq;
                    const u32x2 g = *(const u32x2*)(G + (size_t)row * 2048 + 1024 + col);
                    const f32x4 v0 = acc[ai][bj][m][0] * (MSCALE / 255.0f), v1 = acc[ai][bj][m][1] * (MSCALE / 255.0f);
                    u32x2 w; w.x = pk4_fp8(UB(g.x, 0) * v0[0], UB(g.x, 1) * v0[1], UB(g.x, 2) * v0[2], UB(g.x, 3) * v0[3]); w.y = pk4_fp8(UB(g.y, 0) * v1[0], UB(g.y, 1) * v1[1], UB(g.y, 2) * v1[2], UB(g.y, 3) * v1[3]);
                    *(u32x2*)((unsigned char*)M + (size_t)row * 1024 + col) = w;
                }
            }
    }
};
struct EpiResF32 {
    static constexpr bool PERM = true, HAS_MID = false, HAS_PRE = false;
    bf16_t* Y;
    __device__ __forceinline__ void operator()(const f32x4 (&acc)[2][2][4][2], const Unit& u, int wr, int wc, int fr, int fq) const {
        const int cw = u.pn * BM + wc * 32 + 8 * fq;
#pragma unroll
        for (int ai = 0; ai < 2; ++ai)
#pragma unroll
            for (int m = 0; m < 4; ++m) {
                const int row = u.pm * BM + ai * HALF + wr * 64 + m * 16 + fr;
#pragma unroll
                for (int bj = 0; bj < 2; ++bj) { const f32x4 v0 = acc[ai][bj][m][0], v1 = acc[ai][bj][m][1];
                    u32x4 w; w.x = pk2(v0[0], v0[1]); w.y = pk2(v0[2], v0[3]); w.z = pk2(v1[0], v1[1]); w.w = pk2(v1[2], v1[3]);
                    *(u32x4*)(Y + (size_t)row * DM + cw + bj * HALF) = w; }
            }
    }
};
constexpr int EPI_PRE_OFF = STAGE_BYTES;
struct EpiSwiglu {
    static constexpr bool PERM = true, HAS_MID = false, HAS_PRE = true;
    unsigned char* H; const float* b1p; LAS unsigned char* lds;
    __device__ __forceinline__ void pre(LAS unsigned char* l, const Unit& u, int wid) const {
        if (wid == 0) { int lane; asm volatile("v_mbcnt_lo_u32_b32 %0, -1, 0\n\tv_mbcnt_hi_u32_b32 %0, -1, %0" : "=v"(lane));
            __builtin_amdgcn_global_load_lds((const unsigned*)(b1p + (size_t)u.e * 2048 + u.pn * BM + lane * 4), (LAS unsigned*)(l + EPI_PRE_OFF + u.par * 2048), 16, 0, 0); }
    }
    __device__ __forceinline__ void operator()(const f32x4 (&acc)[2][2][4][2], const Unit& u, int wr, int wc, int fr, int fq) const {
        const int cw = wc * 32 + 8 * fq; const LAS float* bb = (const LAS float*)(lds + EPI_PRE_OFF + u.par * 2048) + cw;
        const f32x4 bg0 = *(const LAS f32x4*)(bb), bg1 = *(const LAS f32x4*)(bb + 4), bl0 = *(const LAS f32x4*)(bb + HALF), bl1 = *(const LAS f32x4*)(bb + HALF + 4);
#pragma unroll
        for (int ai = 0; ai < 2; ++ai)
#pragma unroll
            for (int m = 0; m < 4; ++m) {
                const int row = u.pm * BM + ai * HALF + wr * 64 + m * 16 + fr;
                const f32x4 g0 = acc[ai][0][m][0] + bg0, g1 = acc[ai][0][m][1] + bg1, l0 = acc[ai][1][m][0] + bl0, l1 = acc[ai][1][m][1] + bl1;
                float o[8];
#pragma unroll
                for (int i = 0; i < 8; ++i) { const float g = fminf(i < 4 ? g0[i & 3] : g1[i & 3], 7.0f); const float l = __builtin_amdgcn_fmed3f(i < 4 ? l0[i & 3] : l1[i & 3], -7.0f, 7.0f);
                    const float r = __builtin_amdgcn_rcpf(1.f + __builtin_amdgcn_exp2f(g * (-1.702f * 1.4426950408889634f)));
                    o[i] = (g * r) * fmaf(l, HSCALE, HSCALE); }
                u32x2 w; w.x = pk4_fp8(o[0], o[1], o[2], o[3]); w.y = pk4_fp8(o[4], o[5], o[6], o[7]);
                *(u32x2*)(H + (size_t)row * 1024 + u.pn * HALF + cw) = w;
            }
    }
};
struct EpiDown {
    static constexpr bool PERM = true, HAS_MID = false, HAS_PRE = true;
    unsigned char* Y; const float* b2; const int* list; LAS unsigned char* lds;
    __device__ __forceinline__ void pre(LAS unsigned char* l, const Unit& u, int wid) const {
        if (wid < 2) { int lane; asm volatile("v_mbcnt_lo_u32_b32 %0, -1, 0\n\tv_mbcnt_hi_u32_b32 %0, -1, %0" : "=v"(lane));
            const unsigned* src = wid == 0 ? (const unsigned*)(b2 + (size_t)u.e * 1024 + u.pn * BM) : (const unsigned*)(list + u.lbase);
            __builtin_amdgcn_global_load_lds(src + lane * 4, (LAS unsigned*)(l + EPI_PRE_OFF + u.par * 2048 + wid * 1024), 16, 0, 0); }
    }
    __device__ __forceinline__ void operator()(const f32x4 (&acc)[2][2][4][2], const Unit& u, int wr, int wc, int fr, int fq) const {
        const int cw = u.pn * BM + wc * 32 + 8 * fq; const LAS float* bb = (const LAS float*)(lds + EPI_PRE_OFF + u.par * 2048) + wc * 32 + 8 * fq;
        const LAS int* ll = (const LAS int*)(lds + EPI_PRE_OFF + u.par * 2048 + 1024);
        int dst[2][4];
#pragma unroll
        for (int ai = 0; ai < 2; ++ai)
#pragma unroll
            for (int m = 0; m < 4; ++m) { const int lr = ai * HALF + wr * 64 + m * 16 + fr; const int v = ll[lr]; dst[ai][m] = lr < u.nv ? v : -1; }
#pragma unroll
        for (int bj = 0; bj < 2; ++bj) {
            const f32x4 bv0 = *(const LAS f32x4*)(bb + bj * HALF), bv1 = *(const LAS f32x4*)(bb + bj * HALF + 4);
#pragma unroll
            for (int ai = 0; ai < 2; ++ai)
#pragma unroll
                for (int m = 0; m < 4; ++m) {
                    const f32x4 v0 = acc[ai][bj][m][0] + bv0, v1 = acc[ai][bj][m][1] + bv1;
                    u32x2 w; w.x = pk4_fp8(v0[0] * YSCALE, v0[1] * YSCALE, v0[2] * YSCALE, v0[3] * YSCALE); w.y = pk4_fp8(v1[0] * YSCALE, v1[1] * YSCALE, v1[2] * YSCALE, v1[3] * YSCALE);
                    if (dst[ai][m] >= 0) *(u32x2*)(Y + (size_t)dst[ai][m] * 1024 + cw + bj * HALF) = w; }
        }
    }
};
}

__device__ __forceinline__ int lane_now() { int l; asm volatile("v_mbcnt_lo_u32_b32 %0, -1, 0\n\tv_mbcnt_hi_u32_b32 %0, -1, %0" : "=v"(l)); return l; }
namespace da {
using bf16 = __hip_bfloat16;
constexpr int NW = 8, QBLK = 32, KVBLK = 64, LDK = 512, UROWS = 128, OLD = 1024;
constexpr float SCALE = 0.125f, THR = 8.f;
constexpr size_t SHM_V = KVBLK * 128 * 2, SHM_K = KVBLK * 128 * 2, SHM_WS = 2 * SHM_V + 2 * SHM_K;
#define KSWZ(row, colB) ((row) * 256 + ((colB) ^ (((row) & 7) << 4)))
#define SBAR() __builtin_amdgcn_sched_barrier(0)
__device__ __forceinline__ int crow(int r, int hi) { return (r & 3) + 8 * (r >> 2) + 4 * hi; }
__device__ __forceinline__ unsigned cvtpk(float lo, float hi) { unsigned r; asm volatile("v_cvt_pk_bf16_f32 %0, %1, %2" : "=v"(r) : "v"(lo), "v"(hi)); return r; }
__device__ __forceinline__ void partialSM(f32x16& p0, f32x16& p1, float& m_reg, float& mn, float& alpha) {
    constexpr float C = SCALE * 1.4426950408889634f;
    float pmax = p0[0];
#pragma unroll
    for (int r = 1; r < 16; ++r) pmax = fmaxf(pmax, p0[r]);
#pragma unroll
    for (int r = 0; r < 16; ++r) pmax = fmaxf(pmax, p1[r]);
    { auto rr = __builtin_amdgcn_permlane32_swap(__float_as_uint(pmax), __float_as_uint(pmax), false, false); pmax = fmaxf(__uint_as_float(rr[0]), __uint_as_float(rr[1])); }
    if (__builtin_expect(__all(pmax - m_reg <= THR / SCALE), 1)) { mn = m_reg; alpha = 1.f; }
    else { mn = fmaxf(m_reg, pmax); alpha = __builtin_amdgcn_exp2f((m_reg - mn) * C); m_reg = mn; }
    const float mnC = -mn * C;
#pragma unroll
    for (int r = 0; r < 16; ++r) p0[r] = fmaf(p0[r], C, mnC);
#pragma unroll
    for (int r = 0; r < 16; ++r) p1[r] = fmaf(p1[r], C, mnC);
#pragma unroll
    for (int r = 0; r < 16; ++r) p0[r] = __builtin_amdgcn_exp2f(p0[r]);
}
__device__ __forceinline__ void finishSM(f32x16& p0, f32x16& p1, float alpha, float& l_reg, bf16x8& pa0, bf16x8& pa1, bf16x8& pa2, bf16x8& pa3) {
#pragma unroll
    for (int r = 0; r < 16; ++r) p1[r] = __builtin_amdgcn_exp2f(p1[r]);
    float ps = 0;
#pragma unroll
    for (int r = 0; r < 16; ++r) ps += p0[r];
#pragma unroll
    for (int r = 0; r < 16; ++r) ps += p1[r];
    { auto rr = __builtin_amdgcn_permlane32_swap(__float_as_uint(ps), __float_as_uint(ps), false, false); ps = __uint_as_float(rr[0]) + __uint_as_float(rr[1]); }
    l_reg = l_reg * alpha + ps;
#define PK4(P, BASE, OUT) do { u32x4 w = {pk2(P[BASE + 0], P[BASE + 1]), pk2(P[BASE + 2], P[BASE + 3]), pk2(P[BASE + 4], P[BASE + 5]), pk2(P[BASE + 6], P[BASE + 7])}; \
    OUT = *reinterpret_cast<bf16x8*>(&w); } while (0)
    PK4(p0, 0, pa0); PK4(p0, 8, pa1); PK4(p1, 0, pa2); PK4(p1, 8, pa3);
#undef PK4
}
__device__ __forceinline__ void qkt(f32x16& p0, f32x16& p1, const char* Ks, const bf16x8* qr, int r32, int hi) {
    p0 = f32x16{}; p1 = f32x16{};
#pragma unroll
    for (int d0 = 0; d0 < 4; ++d0) { const int cb = (d0 * 16 + hi * 8) * 2;
        const bf16x8 b0 = *reinterpret_cast<const bf16x8*>(Ks + KSWZ(r32, cb));
        const bf16x8 b1 = *reinterpret_cast<const bf16x8*>(Ks + KSWZ(32 + r32, cb));
        p0 = __builtin_amdgcn_mfma_f32_32x32x16_bf16(b0, qr[d0], p0, 0, 0, 0);
        p1 = __builtin_amdgcn_mfma_f32_32x32x16_bf16(b1, qr[d0], p1, 0, 0, 0); }
}
constexpr float THR_L2 = 11.541560327111707f;
#define KSWZ16(row, colB) ((row) * 256 + ((colB) ^ (((row) & 15) << 4)))
__device__ __forceinline__ void qkt2(f32x16& p0, f32x16& p1, const char* Ks, const bf16x8* qr, const f32x16& negm, int r32, int hi, int cofs) {
#pragma unroll
    for (int d0 = 0; d0 < 4; ++d0) { const int cb = cofs + (d0 * 16 + hi * 8) * 2;
        const bf16x8 b0 = *reinterpret_cast<const bf16x8*>(Ks + KSWZ16(r32, cb));
        const bf16x8 b1 = *reinterpret_cast<const bf16x8*>(Ks + KSWZ16(32 + r32, cb));
        if (d0 == 0) { p0 = __builtin_amdgcn_mfma_f32_32x32x16_bf16(b0, qr[0], negm, 0, 0, 0); p1 = __builtin_amdgcn_mfma_f32_32x32x16_bf16(b1, qr[0], negm, 0, 0, 0); }
        else { p0 = __builtin_amdgcn_mfma_f32_32x32x16_bf16(b0, qr[d0], p0, 0, 0, 0); p1 = __builtin_amdgcn_mfma_f32_32x32x16_bf16(b1, qr[d0], p1, 0, 0, 0); } }
}
__device__ __forceinline__ void kfrag8(bf16x8 (&kf)[8], const char* Ks, int r32, int hi, int cofs) {
#pragma unroll
    for (int d0 = 0; d0 < 4; ++d0) { const int cb = cofs + (d0 * 16 + hi * 8) * 2;
        kf[2 * d0] = *reinterpret_cast<const bf16x8*>(Ks + KSWZ16(r32, cb)); kf[2 * d0 + 1] = *reinterpret_cast<const bf16x8*>(Ks + KSWZ16(32 + r32, cb)); }
}
__device__ __forceinline__ void qk_mma(f32x16& p0, f32x16& p1, const bf16x8 (&kf)[8], const bf16x8* qr, const f32x16& negm) {
    p0 = __builtin_amdgcn_mfma_f32_32x32x16_bf16(kf[0], qr[0], negm, 0, 0, 0); p1 = __builtin_amdgcn_mfma_f32_32x32x16_bf16(kf[1], qr[0], negm, 0, 0, 0);
#pragma unroll
    for (int d0 = 1; d0 < 4; ++d0) { p0 = __builtin_amdgcn_mfma_f32_32x32x16_bf16(kf[2 * d0], qr[d0], p0, 0, 0, 0); p1 = __builtin_amdgcn_mfma_f32_32x32x16_bf16(kf[2 * d0 + 1], qr[d0], p1, 0, 0, 0); }
}
template <bool FIRST>
__device__ __forceinline__ void psm2(f32x16& p0, f32x16& p1, float& m, f32x16& negm, float& alpha) {
    float a = fmaxf(fmaxf(p0[0], p0[1]), p1[0]), b = fmaxf(fmaxf(p0[2], p0[3]), p1[1]); a = fmaxf(fmaxf(a, p1[2]), p1[3]);
#pragma unroll
    for (int r = 4; r < 16; r += 4) { a = fmaxf(fmaxf(a, p0[r]), p0[r + 1]); b = fmaxf(fmaxf(b, p0[r + 2]), p0[r + 3]); a = fmaxf(fmaxf(a, p1[r]), p1[r + 1]); b = fmaxf(fmaxf(b, p1[r + 2]), p1[r + 3]); }
    float pmax = fmaxf(a, b);
    { auto rr = __builtin_amdgcn_permlane32_swap(__float_as_uint(pmax), __float_as_uint(pmax), false, false); pmax = fmaxf(__uint_as_float(rr[0]), __uint_as_float(rr[1])); }
    if (FIRST || !__all(pmax <= THR_L2)) {
        const float dl = FIRST ? pmax : fmaxf(pmax, 0.f);
        alpha = FIRST ? 0.f : __builtin_amdgcn_exp2f(-dl); m += dl;
#pragma unroll
        for (int r = 0; r < 16; ++r) { p0[r] -= dl; p1[r] -= dl; }
        const float nm = -m;
#pragma unroll
        for (int r = 0; r < 16; ++r) negm[r] = nm;
    } else alpha = 1.f;
#pragma unroll
    for (int r = 0; r < 16; ++r) p0[r] = __builtin_amdgcn_exp2f(p0[r]);
}
__device__ __forceinline__ void fsm2(f32x16& p0, f32x16& p1, float alpha, float& l_reg, bf16x8& pa0, bf16x8& pa1, bf16x8& pa2, bf16x8& pa3) {
#pragma unroll
    for (int r = 0; r < 16; ++r) p1[r] = __builtin_amdgcn_exp2f(p1[r]);
    f32x2 acc2 = {p0[0], p0[1]};
#pragma unroll
    for (int i = 1; i < 8; ++i) acc2 += (f32x2){p0[2 * i], p0[2 * i + 1]};
#pragma unroll
    for (int i = 0; i < 8; ++i) acc2 += (f32x2){p1[2 * i], p1[2 * i + 1]};
    float ps = acc2[0] + acc2[1];
    { auto rr = __builtin_amdgcn_permlane32_swap(__float_as_uint(ps), __float_as_uint(ps), false, false); ps = __uint_as_float(rr[0]) + __uint_as_float(rr[1]); }
    l_reg = l_reg * alpha + ps;
#define PK4(P, BASE, OUT) do { u32x4 w = {pk2(P[BASE + 0], P[BASE + 1]), pk2(P[BASE + 2], P[BASE + 3]), pk2(P[BASE + 4], P[BASE + 5]), pk2(P[BASE + 6], P[BASE + 7])}; \
    OUT = *reinterpret_cast<bf16x8*>(&w); } while (0)
    PK4(p0, 0, pa0); PK4(p0, 8, pa1); PK4(p1, 0, pa2); PK4(p1, 8, pa3);
#undef PK4
}
__device__ __forceinline__ float psm_max(const f32x16& p0, const f32x16& p1) {
    float a = fmaxf(fmaxf(p0[0], p0[1]), p1[0]), b = fmaxf(fmaxf(p0[2], p0[3]), p1[1]); a = fmaxf(fmaxf(a, p1[2]), p1[3]);
#pragma unroll
    for (int r = 4; r < 16; r += 4) { a = fmaxf(fmaxf(a, p0[r]), p0[r + 1]); b = fmaxf(fmaxf(b, p0[r + 2]), p0[r + 3]); a = fmaxf(fmaxf(a, p1[r]), p1[r + 1]); b = fmaxf(fmaxf(b, p1[r + 2]), p1[r + 3]); }
    return fmaxf(a, b);
}
__device__ __forceinline__ void psm_decide(f32x16& p0, f32x16& p1, float pmax, float& m, f32x16& negm, float& alpha) {
    { auto rr = __builtin_amdgcn_permlane32_swap(__float_as_uint(pmax), __float_as_uint(pmax), false, false); pmax = fmaxf(__uint_as_float(rr[0]), __uint_as_float(rr[1])); }
    if (!__all(pmax <= THR_L2)) {
        const float dl = fmaxf(pmax, 0.f);
        alpha = __builtin_amdgcn_exp2f(-dl); m += dl;
#pragma unroll
        for (int r = 0; r < 16; ++r) { p0[r] -= dl; p1[r] -= dl; }
        const float nm = -m;
#pragma unroll
        for (int r = 0; r < 16; ++r) negm[r] = nm;
    } else alpha = 1.f;
}
template <int LO, int HI> __device__ __forceinline__ void psm_exp(f32x16& p) {
#pragma unroll
    for (int r = LO; r < HI; ++r) p[r] = __builtin_amdgcn_exp2f(p[r]);
}
__device__ __forceinline__ void fsm3(f32x16& p0, f32x16& p1, float alpha, float& l_reg, bf16x8& pa0, bf16x8& pa1, bf16x8& pa2, bf16x8& pa3) {
    f32x2 s0 = {p0[0], p0[1]}, s1 = {p0[2], p0[3]}, s2 = {p1[0], p1[1]}, s3 = {p1[2], p1[3]};
#pragma unroll
    for (int i = 1; i < 4; ++i) { s0 += (f32x2){p0[4 * i], p0[4 * i + 1]}; s1 += (f32x2){p0[4 * i + 2], p0[4 * i + 3]}; s2 += (f32x2){p1[4 * i], p1[4 * i + 1]}; s3 += (f32x2){p1[4 * i + 2], p1[4 * i + 3]}; }
    s0 += s1; s2 += s3; s0 += s2;
    l_reg += s0[0] + s0[1];
#define PK4(P, BASE, OUT) do { u32x4 w = {pk2(P[BASE + 0], P[BASE + 1]), pk2(P[BASE + 2], P[BASE + 3]), pk2(P[BASE + 4], P[BASE + 5]), pk2(P[BASE + 6], P[BASE + 7])}; \
    OUT = *reinterpret_cast<bf16x8*>(&w); } while (0)
    PK4(p0, 0, pa0); PK4(p0, 8, pa1); PK4(p1, 0, pa2); PK4(p1, 8, pa3);
#undef PK4
}
__device__ __forceinline__ int v_st(int k, int c) { const int kk = (k & ~0xC) | ((k & 4) << 1) | ((k & 8) >> 1); return ((kk >> 3) * 4 + (c >> 5)) * 512 + ((kk & 7) * 32 + (c & 31)) * 2; }
__device__ __forceinline__ int v_rd_base(int lane) { return ((lane & 3) << 3) | (((lane >> 2) & 3) << 6) | (((lane >> 4) & 1) << 5) | (((lane >> 5) & 1) << 8); }
constexpr int v_rd_off(int d0, int ks, int half) { return d0 * 512 + ks * 4096 + half * 2048; }
template <int OFF> __device__ __forceinline__ s16x4 tr_read(int vb) { s16x4 r; asm volatile("ds_read_b64_tr_b16 %0, %1 offset:%2" : "=&v"(r) : "v"(vb), "i"(OFF) : "memory"); return r; }
template <int D0> __device__ __forceinline__ void pv_one(f32x16& od, int vb, bf16x8 pa0, bf16x8 pa1, bf16x8 pa2, bf16x8 pa3) {
    const s16x4 l0 = tr_read<v_rd_off(D0, 0, 0)>(vb), h0 = tr_read<v_rd_off(D0, 0, 1)>(vb), l1 = tr_read<v_rd_off(D0, 1, 0)>(vb), h1 = tr_read<v_rd_off(D0, 1, 1)>(vb);
    const s16x4 l2 = tr_read<v_rd_off(D0, 2, 0)>(vb), h2 = tr_read<v_rd_off(D0, 2, 1)>(vb), l3 = tr_read<v_rd_off(D0, 3, 0)>(vb), h3 = tr_read<v_rd_off(D0, 3, 1)>(vb);
    asm volatile("s_waitcnt lgkmcnt(0)" ::: "memory"); SBAR();
#define PK(L, H) (bf16x8){L[0], L[1], L[2], L[3], H[0], H[1], H[2], H[3]}
    od = __builtin_amdgcn_mfma_f32_32x32x16_bf16(pa0, PK(l0, h0), od, 0, 0, 0);
    od = __builtin_amdgcn_mfma_f32_32x32x16_bf16(pa1, PK(l1, h1), od, 0, 0, 0);
    od = __builtin_amdgcn_mfma_f32_32x32x16_bf16(pa2, PK(l2, h2), od, 0, 0, 0);
    od = __builtin_amdgcn_mfma_f32_32x32x16_bf16(pa3, PK(l3, h3), od, 0, 0, 0);
#undef PK
}
typedef short v4i16_t __attribute__((ext_vector_type(4)));
__device__ __forceinline__ s16x4 vtr(const LAS char* p) { return __builtin_bit_cast(s16x4, __builtin_amdgcn_ds_read_tr16_b64_v4i16((LAS v4i16_t*)p)); }
template <int D0, int KS> __device__ __forceinline__ bf16x8 vfrag(const LAS char* vp) {
    const s16x4 lo = vtr(vp + v_rd_off(D0, KS, 0)), hi = vtr(vp + v_rd_off(D0, KS, 1));
    return (bf16x8){lo[0], lo[1], lo[2], lo[3], hi[0], hi[1], hi[2], hi[3]};
}
#define SGB_MFMA(n) __builtin_amdgcn_sched_group_barrier(0x008, (n), 0)
#define SGB_DSR(n)  __builtin_amdgcn_sched_group_barrier(0x100, (n), 0)
#define SGB_VALU(n) __builtin_amdgcn_sched_group_barrier(0x002, (n), 0)
#define SGB_TRANS(n) __builtin_amdgcn_sched_group_barrier(0x400, (n), 0)
#define SGB_VMEM(n) __builtin_amdgcn_sched_group_barrier(0x010, (n), 0)
template <int KS> __device__ __forceinline__ void pv_ks(f32x16* o, int vb, bf16x8 pa) {
    const s16x4 l0 = tr_read<v_rd_off(0, KS, 0)>(vb), h0 = tr_read<v_rd_off(0, KS, 1)>(vb), l1 = tr_read<v_rd_off(1, KS, 0)>(vb), h1 = tr_read<v_rd_off(1, KS, 1)>(vb);
    const s16x4 l2 = tr_read<v_rd_off(2, KS, 0)>(vb), h2 = tr_read<v_rd_off(2, KS, 1)>(vb), l3 = tr_read<v_rd_off(3, KS, 0)>(vb), h3 = tr_read<v_rd_off(3, KS, 1)>(vb);
    asm volatile("s_waitcnt lgkmcnt(0)" ::: "memory"); SBAR();
#define PK(L, H) (bf16x8){L[0], L[1], L[2], L[3], H[0], H[1], H[2], H[3]}
    o[0] = __builtin_amdgcn_mfma_f32_32x32x16_bf16(pa, PK(l0, h0), o[0], 0, 0, 0);
    o[1] = __builtin_amdgcn_mfma_f32_32x32x16_bf16(pa, PK(l1, h1), o[1], 0, 0, 0);
    o[2] = __builtin_amdgcn_mfma_f32_32x32x16_bf16(pa, PK(l2, h2), o[2], 0, 0, 0);
    o[3] = __builtin_amdgcn_mfma_f32_32x32x16_bf16(pa, PK(l3, h3), o[3], 0, 0, 0);
#undef PK
}
__device__ __forceinline__ void pv_d0(f32x16* o, int vb, bf16x8 pa0, bf16x8 pa1, bf16x8 pa2, bf16x8 pa3) {
    pv_ks<0>(o, vb, pa0); pv_ks<1>(o, vb, pa1); pv_ks<2>(o, vb, pa2); pv_ks<3>(o, vb, pa3);
}
template <int CH> __device__ __forceinline__ void na_fix_exp(f32x16& p0, f32x16& p1, unsigned vm, const float* bt) {
#pragma unroll
    for (int r = 0; r < 16; ++r) { const int ko = (r & 3) + 8 * (r >> 2);
        const bool l0 = (CH == 0) || (r >= 12), l1 = (CH == 1) || (r < 4);
        if (l0) p0[r] = __builtin_amdgcn_exp2f(((vm >> r) & 1u) ? p0[r] + bt[ko] : -30000.f); else p0[r] = 0.f;
        if (l1) p1[r] = __builtin_amdgcn_exp2f(((vm >> (16 + r)) & 1u) ? p1[r] + bt[32 + ko] : -30000.f); else p1[r] = 0.f; }
}
template <int CH> __device__ __forceinline__ void na_finish(const f32x16& p0, const f32x16& p1, float& l_reg, bf16x8& pa0, bf16x8& pa1, bf16x8& pa2, bf16x8& pa3) {
    float ps = 0.f;
#pragma unroll
    for (int r = 0; r < 16; ++r) { if ((CH == 0) || (r >= 12)) ps += p0[r]; if ((CH == 1) || (r < 4)) ps += p1[r]; }
    l_reg += ps;
#define PKD(P, BASE, OUT) do { u32x4 w = {pk2(P[BASE + 0], P[BASE + 1]), pk2(P[BASE + 2], P[BASE + 3]), pk2(P[BASE + 4], P[BASE + 5]), pk2(P[BASE + 6], P[BASE + 7])}; OUT = *reinterpret_cast<bf16x8*>(&w); } while (0)
    if constexpr (CH == 0) { PKD(p0, 0, pa0); PKD(p0, 8, pa1); PKD(p1, 0, pa2); pa3 = pa2; }
    else { PKD(p0, 8, pa1); PKD(p1, 0, pa2); PKD(p1, 8, pa3); pa0 = pa1; }
#undef PKD
}
template <int CH, int COMP> __device__ __forceinline__ void na_pv(f32x16* o, const LAS char* vp, bf16x8 pa0, bf16x8 pa1, bf16x8 pa2, bf16x8 pa3) {
#define NA_KS(KS, PA) do { const bf16x8 f0 = vfrag<2 * COMP, KS>(vp), f1 = vfrag<2 * COMP + 1, KS>(vp); \
        o[0] = __builtin_amdgcn_mfma_f32_32x32x16_bf16(PA, f0, o[0], 0, 0, 0); o[1] = __builtin_amdgcn_mfma_f32_32x32x16_bf16(PA, f1, o[1], 0, 0, 0); } while (0)
    if constexpr (CH == 0) { NA_KS(0, pa0); NA_KS(1, pa1); NA_KS(2, pa2); } else { NA_KS(1, pa1); NA_KS(2, pa2); NA_KS(3, pa3); }
#undef NA_KS
}
constexpr int L2_K = 0, L2_V = 3 * 16384, L2_WS = 6 * 16384, L2_BIAS = L2_WS + 2048, L2_END = L2_BIAS + 8 * 465 * 4;
template <int MODE>
__device__ __forceinline__ void attn_unit2(const bf16* __restrict__ Qb, const bf16* __restrict__ Kh, const bf16* __restrict__ Vh, bf16_t* __restrict__ Ob,
                                           const float lam, const float* __restrict__ subg, const int NT, char* lds,
                                           const int r0, const int R0, const int hp, const float* bias8, const volatile LAS unsigned* kmw) {
    constexpr int ND = MODE ? 2 : 4;
    const int tid = threadIdx.x, wid = __builtin_amdgcn_readfirstlane(tid >> 6), lane = tid & 63, r32 = lane & 31, hi = lane >> 5;
    const int comp = wid >> 2, qg = wid & 3;
    float* ws = (float*)(lds + L2_WS) + wid * 64; float* li_l = ws; float* al_l = ws + 32;
    float m_reg = 0.f, l_reg = 0; f32x16 o[ND] = {}; f32x16 negm = {}; bf16x8 qr[4];
    const bf16* Qw = Qb + (long)(qg * QBLK + r32) * LDK + comp * 64 + hi * 8;
#pragma unroll
    for (int d0 = 0; d0 < 4; ++d0) qr[d0] = *reinterpret_cast<const bf16x8*>(Qw + d0 * 16);
    if constexpr (MODE == 0) {
        float qs = 0.f;
#pragma unroll
        for (int d0 = 0; d0 < 4; ++d0)
#pragma unroll
            for (int j = 0; j < 8; ++j) { const float x = __uint_as_float((unsigned)(unsigned short)qr[d0][j] << 16); qs = fmaf(x, x, qs); }
        { auto rr = __builtin_amdgcn_permlane32_swap(__float_as_uint(qs), __float_as_uint(qs), false, false); qs = __uint_as_float(rr[0]) + __uint_as_float(rr[1]); }
        const float km2 = __uint_as_float(kmw[comp * 2]) + __uint_as_float(kmw[comp * 2 + 1]);
        const float ref = fminf(sqrtf(qs * km2) * 1.02f + 0.01f, 64.f);
#pragma unroll
        for (int r = 0; r < 16; ++r) negm[r] = -ref;
    }
    unsigned vmask = 0u; const float* bt0 = bias8; int rimg = 0;
    if constexpr (MODE == 1) {
        const int c = (qg & 1) * 32 + r32, cs0 = min(max(c - 8, 0), 48); rimg = r0 + (qg >> 1);
#pragma unroll
        for (int r = 0; r < 16; ++r) { const int kc = crow(r, hi); if ((unsigned)(kc - cs0) < 16u) vmask |= 1u << r; if ((unsigned)(kc + 32 - cs0) < 16u) vmask |= 1u << (16 + r); }
        bt0 = bias8 + (hp * 2 + comp) * 465 + (15 - c + 4 * hi);
    }
    const int rs_w = min(max(rimg - 4, 0), 120);
    const int ch = qg & 1;
    if constexpr (MODE == 1) {
        float qs = 0.f;
#pragma unroll
        for (int d0 = 0; d0 < 4; ++d0)
#pragma unroll
            for (int j = 0; j < 8; ++j) { const float x = __uint_as_float((unsigned)(unsigned short)qr[d0][j] << 16); qs = fmaf(x, x, qs); }
        { auto rr = __builtin_amdgcn_permlane32_swap(__float_as_uint(qs), __float_as_uint(qs), false, false); qs = __uint_as_float(rr[0]) + __uint_as_float(rr[1]); }
        const float km2 = __uint_as_float(kmw[comp * 2]) + __uint_as_float(kmw[comp * 2 + 1]);
        const float ref = fminf(sqrtf(qs * km2) * 1.02f + lam + 0.01f, 64.f);
#pragma unroll
        for (int r = 0; r < 16; ++r) negm[r] = -ref;
    }
    unsigned koff[2], voff[2];
#pragma unroll
    for (int i = 0; i < 2; ++i) { const int jj = 2 * wid + i;
        { const int row = 4 * jj + (lane >> 4), c16 = (lane & 15) ^ (row & 15); koff[i] = (unsigned)(row * 1024 + c16 * 16); }
        { const int st = 2 * jj + (lane >> 5), w = (lane & 31) * 16, kk = (st >> 2) * 8 + (w >> 6), k = kk, c = (st & 3) * 32 + ((w & 63) >> 4) * 8;
          voff[i] = (unsigned)(k * 1024 + c * 2); } }
    LAS unsigned char* ldsl = (LAS unsigned char*)lds;
    const unsigned pw = (unsigned)wid * 2048u;
#define KROW2(t) ((MODE ? (min(R0 + min((t), NT - 1), 127) * 64) : (min((t), NT - 1) * KVBLK)))
    const __amdgpu_buffer_rsrc_t srdK = __builtin_amdgcn_make_buffer_rsrc((void*)Kh, (short)0, SEQ * 1024, 0x00020000);
    const __amdgpu_buffer_rsrc_t srdV = __builtin_amdgcn_make_buffer_rsrc((void*)Vh, (short)0, SEQ * 1024, 0x00020000);
#define DMAK(t, slot) do { const int so_ = KROW2(t) * 1024; _Pragma("unroll") for (int i_ = 0; i_ < 2; ++i_) \
        __builtin_amdgcn_raw_ptr_buffer_load_lds(srdK, (LAS void*)(ldsl + L2_K + (slot) * 16384 + pw + i_ * 1024), 16, (int)koff[i_], so_, 0, 0); } while (0)
#define DMAV(t, slot) do { const int so_ = KROW2(t) * 1024; _Pragma("unroll") for (int i_ = 0; i_ < 2; ++i_) \
        __builtin_amdgcn_raw_ptr_buffer_load_lds(srdV, (LAS void*)(ldsl + L2_V + (slot) * 16384 + pw + i_ * 1024), 16, (int)voff[i_], so_, 0, 0); } while (0)
#define WAITBAR(N) asm volatile("s_waitcnt vmcnt(" #N ") lgkmcnt(0)\n\ts_barrier" ::: "memory")
#define FIXUP(P0, P1, t) do { if constexpr (MODE == 1) { const int trow = R0 + (t); const bool tv = (trow >= rs_w) && (trow < rs_w + 8); const unsigned vm = tv ? vmask : 0u; \
        const int ro = min(max(trow - rimg + 7, 0), 14); const float* bt = bt0 + ro * 31; \
        if (ch == 0) na_fix_exp<0>(P0, P1, vm, bt); else na_fix_exp<1>(P0, P1, vm, bt); } } while (0)
#define PVALL(vb) do { if constexpr (MODE == 0) { pv_d0(o, (vb), pa0, pa1, pa2, pa3); } else { \
        if (comp == 0) { pv_one<0>(o[0], (vb), pa0, pa1, pa2, pa3); pv_one<1>(o[1], (vb), pa0, pa1, pa2, pa3); } \
        else { pv_one<2>(o[0], (vb), pa0, pa1, pa2, pa3); pv_one<3>(o[1], (vb), pa0, pa1, pa2, pa3); } } } while (0)
#define RESC(a) do { if (__any((a) < 1.f)) { if (hi == 0) al_l[r32] = (a); asm volatile("s_waitcnt lgkmcnt(0)" ::: "memory"); \
    _Pragma("unroll") for (int d = 0; d < ND; ++d) _Pragma("unroll") for (int r = 0; r < 16; ++r) o[d][r] *= al_l[crow(r, hi)]; } } while (0)
    const int vb0 = (int)(uintptr_t)(lds + L2_V) + v_rd_base(lane);
    const char* Kc = (const char*)lds + L2_K; const int kcofs = comp * 128;
    f32x16 pA0, pA1, pB0, pB1; float mnA, mnB, alA = 1.f, alB = 1.f; bf16x8 pa0, pa1, pa2, pa3;
    DMAK(0, 0); DMAV(0, 0); DMAK(1, 1); DMAK(2, 2); DMAV(1, 1);
    WAITBAR(4);
    qkt2(pA0, pA1, Kc, qr, negm, r32, hi, kcofs); FIXUP(pA0, pA1, 0); if constexpr (MODE == 0) { psm_exp<0, 16>(pA0); psm_exp<0, 16>(pA1); }
    asm volatile("s_waitcnt lgkmcnt(0)\n\ts_barrier" ::: "memory");
#define ITER(C0, C1, alC, N0, N1, mnN, alN, t, HASNEXT, J_) do { constexpr int sc = (J_) % 3, sn = ((J_) + 1) % 3, sp = ((J_) + 2) % 3; \
        SBAR(); bf16x8 kf_[8]; kfrag8(kf_, Kc + sn * 16384, r32, hi, kcofs); \
        DMAK((t) + 3, sc); DMAV((t) + 2, sp); \
        qk_mma(N0, N1, kf_, qr, negm); FIXUP(N0, N1, (t) + 1); \
        if constexpr (MODE == 0) { fsm3(C0, C1, alC, l_reg, pa0, pa1, pa2, pa3); \
            SGB_DSR(8); SGB_VMEM(4); _Pragma("unroll") for (int g_ = 0; g_ < 8; ++g_) { SGB_MFMA(1); SGB_VALU(5); } SBAR(); \
            const int vb_ = vb0 + sc * 16384; float pm_ = 0.f; \
            const LAS char* vp_ = (const LAS char*)(unsigned)vb_; \
              \
            { const bf16x8 f0 = vfrag<0, 0>(vp_), f1 = vfrag<1, 0>(vp_), f2 = vfrag<2, 0>(vp_), f3 = vfrag<3, 0>(vp_); \
              o[0] = __builtin_amdgcn_mfma_f32_32x32x16_bf16(pa0, f0, o[0], 0, 0, 0); o[1] = __builtin_amdgcn_mfma_f32_32x32x16_bf16(pa0, f1, o[1], 0, 0, 0); \
              o[2] = __builtin_amdgcn_mfma_f32_32x32x16_bf16(pa0, f2, o[2], 0, 0, 0); o[3] = __builtin_amdgcn_mfma_f32_32x32x16_bf16(pa0, f3, o[3], 0, 0, 0); \
              (void)pm_; } \
              \
            { const bf16x8 g0 = vfrag<0, 1>(vp_), g1 = vfrag<1, 1>(vp_), g2 = vfrag<2, 1>(vp_), g3 = vfrag<3, 1>(vp_); \
              o[0] = __builtin_amdgcn_mfma_f32_32x32x16_bf16(pa1, g0, o[0], 0, 0, 0); o[1] = __builtin_amdgcn_mfma_f32_32x32x16_bf16(pa1, g1, o[1], 0, 0, 0); \
              o[2] = __builtin_amdgcn_mfma_f32_32x32x16_bf16(pa1, g2, o[2], 0, 0, 0); o[3] = __builtin_amdgcn_mfma_f32_32x32x16_bf16(pa1, g3, o[3], 0, 0, 0); \
              const bf16x8 h0 = vfrag<0, 2>(vp_), h1 = vfrag<1, 2>(vp_), h2 = vfrag<2, 2>(vp_), h3 = vfrag<3, 2>(vp_); \
              o[0] = __builtin_amdgcn_mfma_f32_32x32x16_bf16(pa2, h0, o[0], 0, 0, 0); o[1] = __builtin_amdgcn_mfma_f32_32x32x16_bf16(pa2, h1, o[1], 0, 0, 0); \
              o[2] = __builtin_amdgcn_mfma_f32_32x32x16_bf16(pa2, h2, o[2], 0, 0, 0); o[3] = __builtin_amdgcn_mfma_f32_32x32x16_bf16(pa2, h3, o[3], 0, 0, 0); \
              const bf16x8 i0 = vfrag<0, 3>(vp_), i1 = vfrag<1, 3>(vp_), i2 = vfrag<2, 3>(vp_), i3 = vfrag<3, 3>(vp_); \
              o[0] = __builtin_amdgcn_mfma_f32_32x32x16_bf16(pa3, i0, o[0], 0, 0, 0); o[1] = __builtin_amdgcn_mfma_f32_32x32x16_bf16(pa3, i1, o[1], 0, 0, 0); \
              o[2] = __builtin_amdgcn_mfma_f32_32x32x16_bf16(pa3, i2, o[2], 0, 0, 0); o[3] = __builtin_amdgcn_mfma_f32_32x32x16_bf16(pa3, i3, o[3], 0, 0, 0); \
              if (HASNEXT) { psm_exp<0, 16>(N0); psm_exp<0, 16>(N1); } \
              SGB_DSR(8); \
              _Pragma("unroll") for (int g_ = 0; g_ < 12; ++g_) { SGB_MFMA(1); SGB_DSR(2); SGB_TRANS(2); } \
              SGB_MFMA(1); SGB_TRANS(2); SGB_MFMA(1); SGB_TRANS(2); SGB_MFMA(1); SGB_TRANS(2); SGB_MFMA(1); SGB_TRANS(2); \
              if (HASNEXT) asm volatile("" : "+v"(N0), "+v"(N1)); } \
        } else { if (ch == 0) na_finish<0>(C0, C1, l_reg, pa0, pa1, pa2, pa3); else na_finish<1>(C0, C1, l_reg, pa0, pa1, pa2, pa3); SBAR(); \
            const LAS char* vp_ = (const LAS char*)(unsigned)(vb0 + sc * 16384); \
            if (ch == 0) { if (comp == 0) na_pv<0, 0>(o, vp_, pa0, pa1, pa2, pa3); else na_pv<0, 1>(o, vp_, pa0, pa1, pa2, pa3); } \
            else { if (comp == 0) na_pv<1, 0>(o, vp_, pa0, pa1, pa2, pa3); else na_pv<1, 1>(o, vp_, pa0, pa1, pa2, pa3); } } \
        SBAR(); WAITBAR(4); } while (0)
    int t = 0;
    for (; t + 6 <= NT; t += 6) {
        ITER(pA0, pA1, alA, pB0, pB1, mnB, alB, t, true, 0);     ITER(pB0, pB1, alB, pA0, pA1, mnA, alA, t + 1, true, 1);
        ITER(pA0, pA1, alA, pB0, pB1, mnB, alB, t + 2, true, 2); ITER(pB0, pB1, alB, pA0, pA1, mnA, alA, t + 3, true, 3);
        ITER(pA0, pA1, alA, pB0, pB1, mnB, alB, t + 4, true, 4); ITER(pB0, pB1, alB, pA0, pA1, mnA, alA, t + 5, true, 5);
    }
    if (t < NT)     ITER(pA0, pA1, alA, pB0, pB1, mnB, alB, t, true, 0);
    if (t + 1 < NT) ITER(pB0, pB1, alB, pA0, pA1, mnA, alA, t + 1, true, 1);
    if (t + 2 < NT) ITER(pA0, pA1, alA, pB0, pB1, mnB, alB, t + 2, true, 2);
    if (t + 3 < NT) ITER(pB0, pB1, alB, pA0, pA1, mnA, alA, t + 3, true, 3);
    if (t + 4 < NT) ITER(pA0, pA1, alA, pB0, pB1, mnB, alB, t + 4, true, 4);
    asm volatile("s_waitcnt vmcnt(0)" ::: "memory");
    const int lane_e = lane_now(), r32e = lane_e & 31, hie = lane_e >> 5;
    { auto rr = __builtin_amdgcn_permlane32_swap(__float_as_uint(l_reg), __float_as_uint(l_reg), false, false); l_reg = __uint_as_float(rr[0]) + __uint_as_float(rr[1]); }
    if (hie == 0) li_l[r32e] = l_reg; asm volatile("s_waitcnt lgkmcnt(0)" ::: "memory");
    float rli[16];
#pragma unroll
    for (int r = 0; r < 16; ++r) rli[r] = __builtin_amdgcn_rcpf(li_l[crow(r, hie)]);
    if constexpr (MODE == 0) {
        __syncthreads();
        float* X = (float*)lds + qg * 4096;
        if (comp == 1) {
#pragma unroll
            for (int d0 = 0; d0 < 4; ++d0)
#pragma unroll
                for (int r = 0; r < 16; ++r) X[(d0 * 16 + r) * 64 + lane_e] = o[d0][r] * rli[r] * lam;
        }
        __syncthreads();
        if (comp == 0) {
            float ss[16];
#pragma unroll
            for (int r = 0; r < 16; ++r) ss[r] = 0.f;
#pragma unroll
            for (int d0 = 0; d0 < 4; ++d0)
#pragma unroll
                for (int r = 0; r < 16; ++r) { const float v = o[d0][r] * rli[r] - X[(d0 * 16 + r) * 64 + lane_e]; o[d0][r] = v; ss[r] += v * v; }
#pragma unroll
            for (int r = 0; r < 16; ++r) {
#pragma unroll
                for (int msk = 1; msk < 32; msk <<= 1) ss[r] += __shfl_xor(ss[r], msk);
                ss[r] = (1.0f - LAM_INIT) / sqrtf(ss[r] * (1.0f / 128.0f) + RMS_EPS);
            }
            float gg[4];
#pragma unroll
            for (int d0 = 0; d0 < 4; ++d0) gg[d0] = subg[d0 * 32 + r32e];
            unsigned char* Ow = (unsigned char*)Ob + (long)(qg * QBLK) * OLD;
#pragma unroll
            for (int r = 0; r < 16; ++r) { const int orow = crow(r, hie);
#pragma unroll
                for (int d0 = 0; d0 < 4; ++d0) { const float v = o[d0][r] * ss[r] * gg[d0] * ASCALE; Ow[(long)orow * OLD + d0 * 32 + r32e] = (unsigned char)(pk4_fp8(v, v, v, v) & 0xffu); } }
        }
    } else {
        unsigned char* Ow = (unsigned char*)Ob + (long)(qg * QBLK) * OLD + comp * 64;
#pragma unroll
        for (int r = 0; r < 16; ++r) { const int orow = crow(r, hie);
#pragma unroll
            for (int d0 = 0; d0 < 2; ++d0) { const float v = o[d0][r] * rli[r] * ASCALE; Ow[(long)orow * OLD + d0 * 32 + r32e] = (unsigned char)(pk4_fp8(v, v, v, v) & 0xffu); } }
    }
    __syncthreads();
#undef KROW2
#undef DMAK
#undef DMAV
#undef WAITBAR
#undef FIXUP
#undef PVALL
#undef RESC
#undef ITER
}
#undef KSWZ
#undef KSWZ16
#undef SBAR
}

#define XB_TMO      128
#define XB_XCNT(j)  (256  + 64 * (j))
#define XB_XSUB(j)  (1280 + 64 * (j))
#define XB_XGEN(j)  (2304 + 64 * (j))
#define XB_TOP      3328
#define XB_TOPGEN   3392
#define XCD_BAR_WORDS 3456
#define XB_SPIN_CAP (1u << 18)
__device__ __forceinline__ unsigned xb_ld(unsigned* p)              { return __hip_atomic_load(p, __ATOMIC_RELAXED, __HIP_MEMORY_SCOPE_AGENT); }
__device__ __forceinline__ unsigned xb_add(unsigned* p, unsigned v) { return __hip_atomic_fetch_add(p, v, __ATOMIC_RELAXED, __HIP_MEMORY_SCOPE_AGENT); }
__device__ __forceinline__ unsigned xb_xcc_id() { return (unsigned)__builtin_amdgcn_s_getreg((3 << 11) | 20) & 0xFu; }
#define XB_SPIN(cond, bar) do { unsigned _sp = 0; while (cond) { __builtin_amdgcn_s_sleep(1); \
    if ((++_sp & 255u) == 0u) { if (xb_ld(&(bar)[XB_TMO])) break; if (_sp > XB_SPIN_CAP) { atomicAdd(&(bar)[XB_TMO], 1u); break; } } } } while (0)
struct XcdBarrier { unsigned* bar; unsigned x; volatile LAS unsigned* st; };
__device__ __forceinline__ XcdBarrier xcd_barrier_post(unsigned* bar, volatile LAS unsigned* st) {
    XcdBarrier b; b.bar = bar; b.x = xb_xcc_id(); b.st = st;
    if (threadIdx.x == 0) (void)xb_add(&bar[XB_XCNT(b.x)], 1u);
    return b;
}
__device__ __forceinline__ void xcd_barrier_complete(unsigned* bar, unsigned x, unsigned& nloc, unsigned& nx) {
    const unsigned G = gridDim.x * gridDim.y * gridDim.z;
    unsigned sum, cnt, mine, sp = 0u;
    for (;;) {
        sum = 0u; cnt = 0u; mine = 0u;
#pragma unroll
        for (unsigned j = 0; j < 16; ++j) { const unsigned c = xb_ld(&bar[XB_XCNT(j)]); sum += c; cnt += (c > 0u) ? 1u : 0u; mine = (j == x) ? c : mine; }
        if (sum == G) break;
        __builtin_amdgcn_s_sleep(1);
        if ((++sp & 255u) == 0u) { if (xb_ld(&bar[XB_TMO])) break; if (sp > XB_SPIN_CAP) { atomicAdd(&bar[XB_TMO], 1u); break; } }
    }
    nloc = mine > 0u ? mine : 1u; nx = cnt > 0u ? cnt : 1u;
}
__device__ __forceinline__ void xcd_barrier(const XcdBarrier& b) {
    asm volatile("s_waitcnt vmcnt(0)" ::: "memory");
    __syncthreads();
    if (threadIdx.x == 0) {
        unsigned* bar = b.bar;
        __builtin_amdgcn_s_waitcnt(0);
        unsigned nloc = b.st[0], nx = b.st[1];
        if (nloc == 0u) { xcd_barrier_complete(bar, b.x, nloc, nx); b.st[0] = nloc; b.st[1] = nx; }
        const unsigned old = xb_add(&bar[XB_XSUB(b.x)], 1u);
        const unsigned gen = old / nloc;
        if (old + 1u == (gen + 1u) * nloc) {
            __builtin_amdgcn_fence(__ATOMIC_RELEASE, "agent");
            asm volatile("s_waitcnt vmcnt(0)" ::: "memory");
            const unsigned og = xb_add(&bar[XB_TOP], 1u);
            const unsigned tg = og / nx;
            if (og + 1u == (tg + 1u) * nx) xb_add(&bar[XB_TOPGEN], 1u);
            else XB_SPIN(xb_ld(&bar[XB_TOPGEN]) == tg, bar);
            __builtin_amdgcn_fence(__ATOMIC_ACQUIRE, "agent");
            xb_add(&bar[XB_XGEN(b.x)], 1u);
            asm volatile("s_waitcnt vmcnt(0)" ::: "memory");
        } else {
            XB_SPIN(xb_ld(&bar[XB_XGEN(b.x)]) == gen, bar);
            __builtin_amdgcn_fence(__ATOMIC_ACQUIRE, "agent");
            asm volatile("s_waitcnt vmcnt(0)" ::: "memory");
        }
    }
    __syncthreads();
}

struct Args {
    const float *x, *w_in, *b_in, *lq1, *lk1, *lq2, *lk2, *subg, *rpb, *wda, *wna, *wout, *ln1g, *ln1b, *wr, *br, *w1, *b1, *w2, *b2, *ln2g, *ln2b;
    float* out; unsigned char* ws; int ph_lo, ph_hi;
};
struct Frame {
    LAS unsigned char* lds; volatile LAS unsigned* MISC; unsigned* ctl;
    int tid, lane, wave, G;
};

#ifndef MOE_IN_P2
#define MOE_IN_P2 1
#endif
template <class SrcCol>
__device__ __forceinline__ void transpose_item(const float* W, int K, int N, bf16_t* WT, LAS float* scr, int item, int lane, SrcCol sc, int ldk = 0) {
    if (ldk == 0) ldk = K;
    const int nblk = N / 32, kb = item / nblk, nb = item % nblk, k0 = 64 * kb, n0 = 32 * nb;
    const int scol = sc(n0 + (lane & 31));
    float wv[32];
#pragma unroll
    for (int i = 0; i < 32; ++i) { const int kk = 2 * i + (lane >> 5); wv[i] = W[(size_t)(k0 + kk) * N + scol]; }
#pragma unroll
    for (int i = 0; i < 32; ++i) { const int kk = 2 * i + (lane >> 5); scr[kk * 33 + (lane & 31)] = wv[i]; }
    LDS_WAIT(); asm volatile("" ::: "memory");
    const int c = lane & 7;
#pragma unroll
    for (int j = 0; j < 4; ++j) { const int n = (lane >> 3) + 8 * j; const LAS float* s = scr + (8 * c) * 33 + n;
        u32x4 o; o.x = pk2(s[0 * 33], s[1 * 33]); o.y = pk2(s[2 * 33], s[3 * 33]); o.z = pk2(s[4 * 33], s[5 * 33]); o.w = pk2(s[6 * 33], s[7 * 33]);
        *(GAS u32x4*)(WT + (size_t)(n0 + n) * ldk + k0 + 8 * c) = o; }
    LDS_WAIT(); asm volatile("" ::: "memory");
}
template <class SrcCol>
__device__ __forceinline__ void transpose_item_fp8(const float* W, int K, int N, unsigned char* WT, LAS float* scr, int item, int lane, SrcCol sc, int ldk = 0) {
    if (ldk == 0) ldk = K;
    const int nblk = N / 32, kb = item / nblk, nb = item % nblk, k0 = 64 * kb, n0 = 32 * nb;
    const int scol = sc(n0 + (lane & 31));
    float wv[32];
#pragma unroll
    for (int i = 0; i < 32; ++i) { const int kk = 2 * i + (lane >> 5); wv[i] = W[(size_t)(k0 + kk) * N + scol]; }
#pragma unroll
    for (int i = 0; i < 32; ++i) { const int kk = 2 * i + (lane >> 5); scr[kk * 33 + (lane & 31)] = wv[i]; }
    LDS_WAIT(); asm volatile("" ::: "memory");
    const int c = lane & 3;
#pragma unroll
    for (int j = 0; j < 2; ++j) { const int n = (lane >> 2) + 16 * j; const LAS float* s = scr + (16 * c) * 33 + n;
        u32x4 o;
        o.x = pk4_fp8(s[0 * 33] * WSCALE, s[1 * 33] * WSCALE, s[2 * 33] * WSCALE, s[3 * 33] * WSCALE); o.y = pk4_fp8(s[4 * 33] * WSCALE, s[5 * 33] * WSCALE, s[6 * 33] * WSCALE, s[7 * 33] * WSCALE);
        o.z = pk4_fp8(s[8 * 33] * WSCALE, s[9 * 33] * WSCALE, s[10 * 33] * WSCALE, s[11 * 33] * WSCALE); o.w = pk4_fp8(s[12 * 33] * WSCALE, s[13 * 33] * WSCALE, s[14 * 33] * WSCALE, s[15 * 33] * WSCALE);
        *(GAS u32x4*)(WT + (size_t)(n0 + n) * ldk + k0 + 16 * c) = o; }
    LDS_WAIT(); asm volatile("" ::: "memory");
}
__host__ __device__ __forceinline__ int src_in(int n) { return n < 1024 ? ((n & ~63) + ((n & 63) >> 1) + 32 * (n & 1)) : n; }
__host__ __device__ __forceinline__ int src_w1(int n) { const int pn = n >> 8, p = n & 255; return p < 128 ? 2 * (128 * pn + p) : 2 * (128 * pn + p - 128) + 1; }
struct SrcId { __device__ __forceinline__ int operator()(int n) const { return n; } };
struct SrcIn { __device__ __forceinline__ int operator()(int n) const { return src_in(n); } };
struct SrcW1 { __device__ __forceinline__ int operator()(int n) const { return src_w1(n); } };

template <bool W1MAP>
__device__ __forceinline__ void moe_patch(const float* __restrict__ W, const int N, unsigned char* __restrict__ WT, const int kb, const int cb, const int lane) {
    const int ng = lane & 15, kg = lane >> 4, k0 = 64 * kb + 16 * kg, c0 = 64 * cb + 4 * ng;
    f32x4 v[16];
    const __amdgpu_buffer_rsrc_t rs = __builtin_amdgcn_make_buffer_rsrc((void*)W, (short)0, 0x7FFFFFF0, 0x00020000);
    const int vo = (16 * kg * N + 4 * ng) * 4, so = (64 * kb * N + 64 * cb) * 4;
#pragma unroll
    for (int i = 0; i < 16; ++i) { const u32x4 r = __builtin_amdgcn_raw_buffer_load_b128(rs, vo, so + i * N * 4, 0); v[i] = __builtin_bit_cast(f32x4, r); }
#pragma unroll
    for (int j = 0; j < 4; ++j) {
        u32x4 o;
        o.x = pk4_fp8(v[0][j] * WSCALE, v[1][j] * WSCALE, v[2][j] * WSCALE, v[3][j] * WSCALE);     o.y = pk4_fp8(v[4][j] * WSCALE, v[5][j] * WSCALE, v[6][j] * WSCALE, v[7][j] * WSCALE);
        o.z = pk4_fp8(v[8][j] * WSCALE, v[9][j] * WSCALE, v[10][j] * WSCALE, v[11][j] * WSCALE);   o.w = pk4_fp8(v[12][j] * WSCALE, v[13][j] * WSCALE, v[14][j] * WSCALE, v[15][j] * WSCALE);
        const int sc = c0 + j;
        const int n = W1MAP ? ((sc & ~255) + ((sc & 255) >> 1) + 128 * (sc & 1)) : sc;
        *(GAS u32x4*)(WT + (size_t)n * DM + k0) = o;
    }
}
__device__ __forceinline__ void p0_moe(Frame& F, const Args& a) {
    F.lane = lane_now();
    unsigned char* ws = a.ws;
    const int gw = blockIdx.x * NWAVES + F.wave, NGW = F.G * NWAVES;
    constexpr int P1E = (DM / 128) * (2048 / 64), P2E = (DM / 128) * (DM / 64), NP1 = NE * P1E, NP2 = NE * P2E;
    for (int q = gw; q < NP1 + NP2; q += NGW) {
        if (q < NP1) { const int e = q / P1E, qi = q % P1E, kbp = qi >> 5, cb = qi & 31; const float* W = a.w1 + (size_t)e * DM * 2048; unsigned char* D = (unsigned char*)(ws + WS_W1) + (size_t)e * 2048 * DM;
            moe_patch<true>(W, 2048, D, 2 * kbp, cb, F.lane); moe_patch<true>(W, 2048, D, 2 * kbp + 1, cb, F.lane); }
        else { const int r = q - NP1, e = r / P2E, qi = r % P2E, kbp = qi >> 4, cb = qi & 15; const float* W = a.w2 + (size_t)e * DM * DM; unsigned char* D = (unsigned char*)(ws + WS_W2) + (size_t)e * DM * DM;
            moe_patch<false>(W, DM, D, 2 * kbp, cb, F.lane); moe_patch<false>(W, DM, D, 2 * kbp + 1, cb, F.lane); }
    }
}
__device__ __forceinline__ void p0_prologue(Frame& F, const Args& a) {
    F.lane = lane_now();
    unsigned char* ws = a.ws;
    LAS float* scr = (LAS float*)(F.lds + F.wave * 16384);
    const int gw = blockIdx.x * NWAVES + F.wave, NGW = F.G * NWAVES;
    constexpr int I_IN = (DM / 64) * (INC / 32), I_BR = (512 / 64) * (DM / 32), I_OUT = (DM / 64) * (DM / 32), I_W1E = (DM / 64) * (2048 / 32), I_W2E = (DM / 64) * (DM / 32);
    constexpr int NITEMS = I_IN + 2 * I_BR + I_OUT + (MOE_IN_P2 ? 0 : NE * I_W1E + NE * I_W2E);
    for (int it = gw; it < NITEMS; it += NGW) {
        int r = it;
        if (r < I_IN) { transpose_item_fp8(a.w_in, DM, INC, (unsigned char*)(ws + WS_WIN), scr, r, F.lane, SrcIn()); continue; } r -= I_IN;
        if (r < I_BR) { transpose_item_fp8(a.wda, 512, DM, (unsigned char*)(ws + WS_WDA), scr, r, F.lane, SrcId(), DM); continue; } r -= I_BR;
        if (r < I_BR) { transpose_item_fp8(a.wna, 512, DM, (unsigned char*)(ws + WS_WDA) + 512, scr, r, F.lane, SrcId(), DM); continue; } r -= I_BR;
        if (r < I_OUT) { transpose_item_fp8(a.wout, DM, DM, (unsigned char*)(ws + WS_WOUT), scr, r, F.lane, SrcId()); continue; } r -= I_OUT;
        if (r < NE * I_W1E) { const int e = r / I_W1E, ri = r % I_W1E; transpose_item_fp8(a.w1 + (size_t)e * DM * 2048, DM, 2048, (unsigned char*)(ws + WS_W1) + (size_t)e * 2048 * DM, scr, ri, F.lane, SrcW1()); continue; } r -= NE * I_W1E;
        { const int e = r / I_W2E, ri = r % I_W2E; transpose_item_fp8(a.w2 + (size_t)e * DM * DM, DM, DM, (unsigned char*)(ws + WS_W2) + (size_t)e * DM * DM, scr, ri, F.lane, SrcId()); }
    }
    const int gt = blockIdx.x * NTHR + F.tid, NGT = F.G * NTHR;
    { const f32x4* xs = (const f32x4*)a.x; u32x4* xd = (u32x4*)(ws + WS_XB);
      for (int i0 = gt; i0 < T * DM / 8; i0 += 4 * NGT) { f32x4 p[4], q[4];
#pragma unroll
          for (int u = 0; u < 4; ++u) { const int i = i0 + u * NGT; if (i < T * DM / 8) { p[u] = xs[2 * (size_t)i]; q[u] = xs[2 * (size_t)i + 1]; } }
#pragma unroll
          for (int u = 0; u < 4; ++u) { const int i = i0 + u * NGT; if (i < T * DM / 8) { u32x2 o; o.x = pk4_fp8(p[u][0] * XINSCALE, p[u][1] * XINSCALE, p[u][2] * XINSCALE, p[u][3] * XINSCALE); o.y = pk4_fp8(q[u][0] * XINSCALE, q[u][1] * XINSCALE, q[u][2] * XINSCALE, q[u][3] * XINSCALE); ((u32x2*)xd)[i] = o; } } } }
    { f32x2* cs = (f32x2*)(ws + WS_CS);
      for (int i = gt; i < SEQ * 32; i += NGT) { const int pos = i >> 5, fi = i & 31;
          double inv = 1.0; for (int k = 0; k < fi; ++k) inv *= 0.74989420933245582730;
          const double rev = (double)pos * inv * 0.15915494309189533577;
          const float fr = (float)(rev - __builtin_rint(rev));
          cs[i] = (f32x2){__builtin_amdgcn_cosf(fr), __builtin_amdgcn_sinf(fr)}; } }
    { float* bp = (float*)(ws + WS_BINP); for (int i = gt; i < INC; i += NGT) bp[i] = a.b_in[src_in(i)];
      float* b1p = (float*)(ws + WS_B1P); for (int i = gt; i < NE * 2048; i += NGT) { const int e = i >> 11, n = i & 2047; b1p[i] = a.b1[(size_t)e * 2048 + src_w1(n)]; } }
}

__device__ __forceinline__ void ln1_router_phase(Frame& F, const Args& a) {
    F.lane = lane_now();
    unsigned char* ws = a.ws;
    LAS float* WrT = (LAS float*)F.lds;
    LAS int* hist = (LAS int*)(F.lds + 32 * 1028 * 4);
    LAS int* gbase = hist + 32;
    LAS int* rinfo = gbase + 32;
    const bf16_t* Y1 = (const bf16_t*)(ws + WS_Y1); bf16_t* X1 = (bf16_t*)(ws + WS_X1); unsigned char* X1Q = (unsigned char*)(ws + WS_X1B);
    int* topi = (int*)(ws + WS_TOPI); float* topw = (float*)(ws + WS_TOPW); int* trank = (int*)(ws + WS_RANK); int* list = (int*)(ws + WS_LIST);
    unsigned* gcount = F.ctl + CW_GCOUNT;
    for (int idx = F.tid; idx < DM * NE; idx += NTHR) { const int col = idx >> 5, e = idx & 31; WrT[e * 1028 + col] = a.wr[idx]; }
    f32x4 gv[4], bv[4];
#pragma unroll
    for (int j = 0; j < 4; ++j) { gv[j] = *(const f32x4*)(a.ln1g + 4 * F.lane + 256 * j); bv[j] = *(const f32x4*)(a.ln1b + 4 * F.lane + 256 * j); }
    const int myexp = F.lane >> 1;
    const float mybr = a.br[myexp];
    __syncthreads();
    for (int chunk = blockIdx.x; chunk < T / 128; chunk += F.G) {
        if (F.tid < 32) hist[F.tid] = 0;
        __syncthreads();
        for (int rr = 0; rr < 8; ++rr) {
            f32x4 v[2][4];
#pragma unroll
            for (int q = 0; q < 2; ++q) {
                const int t = chunk * 128 + F.wave * 16 + rr + 8 * q; float s = 0.f;
#pragma unroll
                for (int j = 0; j < 4; ++j) { const u32x2 mm = *(const u32x2*)(Y1 + (size_t)t * DM + 4 * F.lane + 256 * j); const f32x4 xx = *(const f32x4*)(a.x + (size_t)t * DM + 4 * F.lane + 256 * j);
                    v[q][j] = xx * ALPHA + (f32x4){bflo(mm.x), bfhi(mm.x), bflo(mm.y), bfhi(mm.y)}; s += (v[q][j][0] + v[q][j][1]) + (v[q][j][2] + v[q][j][3]); }
                const float mean = wave_sum(s) * (1.f / DM); float s2 = 0.f;
#pragma unroll
                for (int j = 0; j < 4; ++j) { v[q][j] = v[q][j] - mean; s2 += (v[q][j][0] * v[q][j][0] + v[q][j][1] * v[q][j][1]) + (v[q][j][2] * v[q][j][2] + v[q][j][3] * v[q][j][3]); }
                const float rstd = 1.f / sqrtf(wave_sum(s2) * (1.f / DM) + LN_EPS);
#pragma unroll
                for (int j = 0; j < 4; ++j) { v[q][j] = v[q][j] * rstd * gv[j] + bv[j];
                    { u32x2 wb; wb.x = pk2(v[q][j][0], v[q][j][1]); wb.y = pk2(v[q][j][2], v[q][j][3]); *(u32x2*)(X1 + (size_t)t * DM + 4 * F.lane + 256 * j) = wb; }
                    *(unsigned*)(X1Q + (size_t)t * DM + 4 * F.lane + 256 * j) = pk4_fp8(v[q][j][0] * XSCALE, v[q][j][1] * XSCALE, v[q][j][2] * XSCALE, v[q][j][3] * XSCALE); }
            }
            f32x2 vp[4][4];
#pragma unroll
            for (int j = 0; j < 4; ++j)
#pragma unroll
                for (int c = 0; c < 4; ++c) vp[j][c] = (f32x2){v[0][j][c], v[1][j][c]};
            float acc[2][32];
#pragma unroll
            for (int e = 0; e < 32; ++e) { f32x2 sa = {0.f, 0.f}, sb = {0.f, 0.f};
#pragma unroll
                for (int j = 0; j < 4; ++j) { const f32x4 w = *(const LAS f32x4*)(WrT + e * 1028 + 4 * F.lane + 256 * j);
                    sa = __builtin_elementwise_fma(vp[j][0], (f32x2){w[0], w[0]}, sa); sb = __builtin_elementwise_fma(vp[j][1], (f32x2){w[1], w[1]}, sb);
                    sa = __builtin_elementwise_fma(vp[j][2], (f32x2){w[2], w[2]}, sa); sb = __builtin_elementwise_fma(vp[j][3], (f32x2){w[3], w[3]}, sb); }
                const f32x2 st = sa + sb; acc[0][e] = st[0]; acc[1][e] = st[1]; }
#pragma unroll
            for (int q = 0; q < 2; ++q) {
                const int rl_ = F.wave * 16 + rr + 8 * q, t = chunk * 128 + rl_;
#define RS_STEP(NV, MASK) _Pragma("unroll") for (int i = 0; i < (NV); ++i) { const bool up = (F.lane & (MASK)) != 0; const float send = up ? acc[q][i] : acc[q][i + (NV)]; const float keep = up ? acc[q][i + (NV)] : acc[q][i]; acc[q][i] = keep + __shfl_xor(send, (MASK)); }
                RS_STEP(16, 32) RS_STEP(8, 16) RS_STEP(4, 8) RS_STEP(2, 4) RS_STEP(1, 2)
#undef RS_STEP
                float val = acc[q][0] + __shfl_xor(acc[q][0], 1) + mybr;
                float tv[4]; int te[4];
#pragma unroll
                for (int k = 0; k < 4; ++k) { const float mx = wave_max(val); const unsigned long long msk = __ballot(val == mx); const int sel = __builtin_ctzll(msk) >> 1; tv[k] = mx; te[k] = sel; if (myexp == sel) val = -INFINITY; }
                const float e1 = __expf(tv[1] - tv[0]), e2 = __expf(tv[2] - tv[0]), e3 = __expf(tv[3] - tv[0]); const float rs_ = 1.f / (1.f + e1 + e2 + e3);
                if (F.lane < 4) { const int k = F.lane; const int e = k == 0 ? te[0] : k == 1 ? te[1] : k == 2 ? te[2] : te[3]; const float w = (k == 0 ? 1.f : k == 1 ? e1 : k == 2 ? e2 : e3) * rs_;
                    const int lr = atomicAdd((int*)&hist[e], 1); rinfo[rl_ * 4 + k] = (e << 16) | lr; topw[(size_t)t * 4 + k] = w; }
            }
        }
        __syncthreads();
        if (F.tid < 32) gbase[F.tid] = (int)__hip_atomic_fetch_add(gcount + F.tid, (unsigned)hist[F.tid], RLX_AGENT);
        __syncthreads();
        { const int info = rinfo[F.tid], e = info >> 16, rank = gbase[e] + (info & 0xffff), t = chunk * 128 + (F.tid >> 2);
          list[(size_t)e * LCAP + rank] = t * 4 + (F.tid & 3); }
        __syncthreads();
    }
}
__device__ __forceinline__ void build_tile_table(Frame& F) {
    volatile LAS int* tb = (volatile LAS int*)(F.MISC + MW_TB); volatile LAS int* cnt = (volatile LAS int*)(F.MISC + MW_CNT);
    __syncthreads();
    if (F.tid < 64) {
        const int e = F.tid & 31, c = (int)__hip_atomic_load(F.ctl + CW_GCOUNT + e, RLX_AGENT), nt_ = (c + 255) >> 8;
        int incl = nt_;
#pragma unroll
        for (int o = 1; o < 32; o <<= 1) { const int v = __shfl_up(incl, o, 32); if (e >= o) incl += v; }
        if (F.tid < 32) { cnt[e] = c; tb[e] = incl - nt_; if (e == 31) tb[NE] = incl; }
    }
    __syncthreads();
}
__device__ __forceinline__ void final_phase(Frame& F, const Args& a) {
    F.lane = lane_now();
    unsigned char* ws = a.ws;
    const LAS int* tb = (const LAS int*)(F.MISC + MW_TB);
    const bf16_t* X1 = (const bf16_t*)(ws + WS_X1); const unsigned char* Y = (const unsigned char*)(ws + WS_Y);
    const int* topi = (const int*)(ws + WS_TOPI); const float* topw = (const float*)(ws + WS_TOPW); const int* trank = (const int*)(ws + WS_RANK);
    const int gw = blockIdx.x * NWAVES + F.wave, NGW = F.G * NWAVES;
    f32x4 gv[2][2], bv[2][2];
#pragma unroll
    for (int j = 0; j < 2; ++j)
#pragma unroll
        for (int n = 0; n < 2; ++n) { gv[j][n] = *(const f32x4*)(a.ln2g + 512 * j + 8 * F.lane + 4 * n); bv[j][n] = *(const f32x4*)(a.ln2b + 512 * j + 8 * F.lane + 4 * n); }
    for (int t0 = gw; t0 < T; t0 += 2 * NGW) {
        const int tr[2] = {t0, (t0 + NGW < T) ? t0 + NGW : t0};
        f32x4 z[2][2][2]; u32x2 y[2][4][2]; float w[2][4];
#pragma unroll
        for (int q = 0; q < 2; ++q) {
            const int t = tr[q];
#pragma unroll
            for (int k = 0; k < 4; ++k) { w[q][k] = topw[(size_t)t * 4 + k]; const size_t slot = (size_t)t * 4 + k;
#pragma unroll
                for (int j = 0; j < 2; ++j) y[q][k][j] = *(const u32x2*)(Y + slot * DM + 512 * j + 8 * F.lane); w[q][k] *= (1.0f / YSCALE); }
#pragma unroll
            for (int j = 0; j < 2; ++j) { const u32x4 xx = *(const u32x4*)(X1 + (size_t)t * DM + 512 * j + 8 * F.lane);
                z[q][j][0] = (f32x4){bflo(xx.x), bfhi(xx.x), bflo(xx.y), bfhi(xx.y)} * ALPHA; z[q][j][1] = (f32x4){bflo(xx.z), bfhi(xx.z), bflo(xx.w), bfhi(xx.w)} * ALPHA; }
        }
        float s[2] = {0.f, 0.f};
#pragma unroll
        for (int q = 0; q < 2; ++q) {
#pragma unroll
            for (int k = 0; k < 4; ++k)
#pragma unroll
                for (int j = 0; j < 2; ++j) { const u32x2 yy = y[q][k][j];
                    const f32x2 a0 = __builtin_amdgcn_cvt_pk_f32_fp8((int)yy.x, false), a1 = __builtin_amdgcn_cvt_pk_f32_fp8((int)yy.x, true), a2 = __builtin_amdgcn_cvt_pk_f32_fp8((int)yy.y, false), a3 = __builtin_amdgcn_cvt_pk_f32_fp8((int)yy.y, true);
                    z[q][j][0] += (f32x4){a0[0], a0[1], a1[0], a1[1]} * w[q][k]; z[q][j][1] += (f32x4){a2[0], a2[1], a3[0], a3[1]} * w[q][k]; }
#pragma unroll
            for (int j = 0; j < 2; ++j)
#pragma unroll
                for (int n = 0; n < 2; ++n) s[q] += (z[q][j][n][0] + z[q][j][n][1]) + (z[q][j][n][2] + z[q][j][n][3]);
        }
#pragma unroll
        for (int o = 1; o < 64; o <<= 1) { s[0] += __shfl_xor(s[0], o); s[1] += __shfl_xor(s[1], o); }
        float s2[2] = {0.f, 0.f};
#pragma unroll
        for (int q = 0; q < 2; ++q) { const float mean = s[q] * (1.f / DM);
#pragma unroll
            for (int j = 0; j < 2; ++j)
#pragma unroll
                for (int n = 0; n < 2; ++n) { z[q][j][n] = z[q][j][n] - mean; s2[q] += (z[q][j][n][0] * z[q][j][n][0] + z[q][j][n][1] * z[q][j][n][1]) + (z[q][j][n][2] * z[q][j][n][2] + z[q][j][n][3] * z[q][j][n][3]); } }
#pragma unroll
        for (int o = 1; o < 64; o <<= 1) { s2[0] += __shfl_xor(s2[0], o); s2[1] += __shfl_xor(s2[1], o); }
#pragma unroll
        for (int q = 0; q < 2; ++q) { if (q == 1 && t0 + NGW >= T) break; const float rstd = 1.f / sqrtf(s2[q] * (1.f / DM) + LN_EPS);
#pragma unroll
            for (int j = 0; j < 2; ++j)
#pragma unroll
                for (int n = 0; n < 2; ++n) *(f32x4*)(a.out + (size_t)tr[q] * DM + 512 * j + 8 * F.lane + 4 * n) = z[q][j][n] * rstd * gv[j][n] + bv[j][n]; }
    }
}

constexpr int NPHASE = 9;
__global__ void __launch_bounds__(NTHR, 2) hybrid_fwd(Args a) {
    extern __shared__ __attribute__((aligned(16))) unsigned char lds_raw[];
    Frame F;
    F.lds = (LAS unsigned char*)lds_raw; F.MISC = (volatile LAS unsigned*)(F.lds + MISC_OFF);
    F.tid = threadIdx.x; F.lane = lane_now(); F.wave = __builtin_amdgcn_readfirstlane(F.tid >> 6); F.G = gridDim.x;
    unsigned char* ws = a.ws; F.ctl = (unsigned*)(ws + WS_CTL);
    for (int u = F.tid; u < 256; u += NTHR) F.MISC[u] = 0u;
    __syncthreads();
    const int lo = a.ph_lo, hi = a.ph_hi;
    XcdBarrier bar; bar.bar = F.ctl + CW_BAR; bar.x = 0; bar.st = nullptr;
    if (hi - lo > 1) bar = xcd_barrier_post(F.ctl + CW_BAR, F.MISC + MW_BAR);
#define IN(k) (lo <= (k) && (k) < hi)
#define SEAM(k) do { if (IN(k) && IN((k) + 1)) xcd_barrier(bar); } while (0)
#ifndef REP_PH
#define REP_PH -1
#endif
#define NREP(k) (((k) == REP_PH) ? 2 : 1)
#define REPEAT(k) for (int rep_ = 0; rep_ < NREP(k); ++rep_, (rep_ < NREP(k) ? xcd_barrier(bar) : (void)0))
    if (F.wave == 0) { const float p1 = a.lq1[F.lane] * a.lk1[F.lane], p2 = a.lq2[F.lane] * a.lk2[F.lane];
        const float s1 = wave_sum(p1), s2 = wave_sum(p2); if (F.lane == 0) ((volatile LAS float*)F.MISC)[MW_LAM] = __expf(s1) - __expf(s2) + LAM_INIT; }
    __syncthreads();
    const float lam = ((volatile LAS float*)F.MISC)[MW_LAM];

    if (IN(0)) REPEAT(0) { p0_prologue(F, a); } SEAM(0);
    if (IN(1)) REPEAT(1) {
        pg8::DenseOrderOff S; S.init(T, INC, DM / 2, F.G, (int)blockIdx.x, ws + WS_XB, ws + WS_WIN); S.rowb = DM;
        pg8::EpiInProj E{(bf16_t*)(ws + WS_QKV), (unsigned char*)(ws + WS_G), (const float*)(ws + WS_BINP), (const f32x2*)(ws + WS_CS), F.ctl + CW_KMAX, F.lds};
        pg8::gemm_phase<pg8::EpiInProj, pg8::DenseOrderOff, true, true, WS_E8, XIN_E8>(F.lds, DM / 2, S, E);
    } SEAM(1);
    if (IN(2)) {
        const da::bf16* Qd = (const da::bf16*)(ws + WS_QKV); const da::bf16* Kd = Qd + (size_t)T * 512; const da::bf16* Vd = Kd + (size_t)T * 512;
        unsigned char* Ad = (unsigned char*)(ws + WS_ADA);
        const int nun = NBATCH * 4 * (SEQ / da::UROWS);
        const int cslot = MOE_IN_P2 ? (int)((F.G == 256 ? (blockIdx.x >> 3) : blockIdx.x) % 6) : -1;
        bool cdone = !MOE_IN_P2;
        constexpr int MW_KM = 208;
        if (F.G == 256) {
            if (F.tid < 24) { const int w = F.tid & 3, sl = F.tid >> 2; unsigned v;
                if (sl < 2) { const int bh = (blockIdx.x & 7) + 8 * sl; v = __hip_atomic_load(F.ctl + CW_KMAX + (bh >> 2) * 16 + (bh & 3) * 4 + w, RLX_AGENT); }
                else { const int u = (blockIdx.x & 7) * 128 + (blockIdx.x >> 3) * 4 + (sl - 2); v = __hip_atomic_load(F.ctl + CW_KMAX + 64 + (u >> 8) * 16 + (u & 3) * 4 + w, RLX_AGENT); }
                F.MISC[MW_KM + F.tid] = v; }
            __syncthreads();
        }
        REPEAT(20) for (int i = 0;; ++i) {
            int bh, qb;
            if (F.G == 256) { if (i >= 4) break; const int xcd = blockIdx.x & 7, loc = blockIdx.x >> 3; bh = xcd + 8 * (i >> 1); qb = loc + 32 * (i & 1); }
            else { const int u = i * F.G + blockIdx.x; if (u >= nun) break; bh = u >> 6; qb = u & 63; }
            if (!cdone && i == cslot) { __syncthreads(); p0_moe(F, a); __syncthreads(); cdone = true; }
            const int b = bh >> 2, h = bh & 3; const size_t row0 = (size_t)b * SEQ;
            int kms = MW_KM + 4 * (i >> 1);
            if (F.G != 256) { __syncthreads(); if (F.tid < 4) { int tq; asm volatile("v_mov_b32 %0, %1" : "=v"(tq) : "v"(F.tid)); F.MISC[MW_KM + tq] = __hip_atomic_load(F.ctl + CW_KMAX + b * 16 + h * 4 + tq, RLX_AGENT); } __syncthreads(); kms = MW_KM; }
            da::attn_unit2<0>(Qd + (row0 + (size_t)qb * da::UROWS) * 512 + h * 128, Kd + row0 * 512 + h * 128, Vd + row0 * 512 + h * 128,
                             (bf16_t*)(Ad + (row0 + (size_t)qb * da::UROWS) * da::OLD + h * 128), lam, a.subg, SEQ / da::KVBLK, (char*)lds_raw, 0, 0, 0, (const float*)(F.ctl + CW_KMAX) + b * 16 + h * 4, F.MISC + kms);
        }
        if (!cdone && cslot <= 4) { __syncthreads(); p0_moe(F, a); __syncthreads(); cdone = true; }
        REPEAT(21) {
            float* bias8 = (float*)((char*)lds_raw + da::L2_BIAS);
            float bmx = 0.f;
            for (int i = F.tid; i < 8 * 465; i += NTHR) { const float v = a.rpb[i] * 1.4426950408889634f; bias8[i] = v; bmx = fmaxf(bmx, fabsf(v)); }
            bmx = wave_max(bmx); if ((F.tid & 63) == 0) ((volatile LAS float*)F.MISC)[200 + F.wave] = bmx;
            __syncthreads();
            float bmax = 0.f;
#pragma unroll
            for (int w8 = 0; w8 < 8; ++w8) bmax = fmaxf(bmax, ((volatile LAS float*)F.MISC)[200 + w8]);
            const da::bf16* Qn = Qd + 3 * (size_t)T * 512; const da::bf16* Kn = Qn + (size_t)T * 512; const da::bf16* Vn = Kn + (size_t)T * 512;
            unsigned char* An = (unsigned char*)(ws + WS_ADA) + 512;
            for (int i = 0;; ++i) {
                int u;
                if (F.G == 256) { if (i >= 4) break; u = (blockIdx.x & 7) * 128 + (blockIdx.x >> 3) * 4 + i; } else { u = i * F.G + blockIdx.x; if (u >= 1024) break; }
                const int hp = u & 3, rp = (u >> 2) & 63, b = u >> 8, r0 = rp * 2, R0 = min(max(r0 - 4, 0), 120);
                const size_t row0 = (size_t)b * SEQ;
                int kms = MW_KM + 8 + 4 * i;
                if (F.G != 256) { __syncthreads(); if (F.tid < 4) { int tq; asm volatile("v_mov_b32 %0, %1" : "=v"(tq) : "v"(F.tid)); F.MISC[MW_KM + tq] = __hip_atomic_load(F.ctl + CW_KMAX + 64 + b * 16 + hp * 4 + tq, RLX_AGENT); } __syncthreads(); kms = MW_KM; }
                da::attn_unit2<1>(Qn + (row0 + (size_t)r0 * 64) * 512 + hp * 128, Kn + row0 * 512 + hp * 128, Vn + row0 * 512 + hp * 128,
                                 (bf16_t*)(An + (row0 + (size_t)r0 * 64) * da::OLD + hp * 128), bmax, (const float*)(F.ctl + CW_KMAX) + 64 + b * 16 + hp * 4, 9, (char*)lds_raw, r0, R0, hp, bias8, F.MISC + kms);
            }
        }
        if (!cdone) { __syncthreads(); p0_moe(F, a); }
    } SEAM(2);
    if (IN(3)) REPEAT(3) {
        pg8::DenseOrderOff S; S.init(T, DM, DM / 2, F.G, (int)blockIdx.x, ws + WS_ADA, ws + WS_WDA); S.rowb = DM;
        pg8::EpiGate2 E{(bf16_t*)(ws + WS_MERGED), (const unsigned char*)(ws + WS_G)};
        pg8::gemm_phase<pg8::EpiGate2, pg8::DenseOrderOff, true, true, WS_E8, A_E8>(F.lds, DM / 2, S, E);
    } SEAM(3);
    if (IN(4)) REPEAT(4) {
        pg8::DenseOrderOff S; S.init(T, DM, DM / 2, F.G, (int)blockIdx.x, ws + WS_MERGED, ws + WS_WOUT); S.rowb = DM;
        pg8::EpiResF32 E{(bf16_t*)(ws + WS_Y1)};
        pg8::gemm_phase<pg8::EpiResF32, pg8::DenseOrderOff, true, true, WS_E8, M_E8>(F.lds, DM / 2, S, E);
    } SEAM(4);
    if (IN(5)) { ln1_router_phase(F, a); } SEAM(5);
    if (IN(6)) REPEAT(6) {
        build_tile_table(F);
        pg8::GroupedOrder<true> S{(const LAS int*)(F.MISC + MW_TB), (const LAS int*)(F.MISC + MW_CNT), 8, F.G, (int)blockIdx.x, DM / 2, (const char*)(ws + WS_X1B), (const char*)(ws + WS_W1),
                                  0, (size_t)256 * DM, (size_t)2048 * DM, (const int*)(ws + WS_LIST)};
        pg8::EpiSwiglu E{(unsigned char*)(ws + WS_H), (const float*)(ws + WS_B1P), F.lds};
        pg8::gemm_phase<pg8::EpiSwiglu, pg8::GroupedOrder<true>, true, true, WS_E8, XS_E8>(F.lds, DM / 2, S, E);
    } SEAM(6);
    if (IN(7)) REPEAT(7) {
        build_tile_table(F);
        pg8::GroupedOrder<false> S{(const LAS int*)(F.MISC + MW_TB), (const LAS int*)(F.MISC + MW_CNT), 4, F.G, (int)blockIdx.x, DM / 2, (const char*)(ws + WS_H), (const char*)(ws + WS_W2),
                                   (size_t)256 * DM, (size_t)256 * DM, (size_t)DM * DM, nullptr};
        pg8::EpiDown E{(unsigned char*)(ws + WS_Y), a.b2, (const int*)(ws + WS_LIST), F.lds};
        pg8::gemm_phase<pg8::EpiDown, pg8::GroupedOrder<false>, true, true, WS_E8, HS_E8>(F.lds, DM / 2, S, E);
    } SEAM(7);
    if (IN(8)) REPEAT(8) { final_phase(F, a); }
#undef IN
#undef SEAM
}

extern "C" void kernel_launch(void* const* d_in, const int* in_sizes, int n_in, void* d_out, int out_size, void* d_ws, size_t ws_size, hipStream_t stream) {
    static int grid = 0;
    if (grid == 0) {
        if (n_in != 22 || in_sizes[0] != T * DM || out_size != T * DM || ws_size < WS_END) { fprintf(stderr, "kernel_launch: shape / workspace mismatch (n_in %d, ws %zu)\n", n_in, ws_size); grid = -1; return; }
        int dev = 0, cus = 0, per_cu = 0;
        if (hipGetDevice(&dev) != hipSuccess || hipDeviceGetAttribute(&cus, hipDeviceAttributeMultiprocessorCount, dev) != hipSuccess) { grid = -1; return; }
        if (hipFuncSetAttribute((const void*)hybrid_fwd, hipFuncAttributeMaxDynamicSharedMemorySize, LDS_BYTES) != hipSuccess) { fprintf(stderr, "kernel_launch: hipFuncSetAttribute failed\n"); grid = -1; return; }
        if (hipOccupancyMaxActiveBlocksPerMultiprocessor(&per_cu, (const void*)hybrid_fwd, NTHR, LDS_BYTES) != hipSuccess || per_cu < 1) { fprintf(stderr, "kernel_launch: occupancy query says %d\n", per_cu); }
        (void)hipGetLastError();
        grid = cus;
    }
    if (grid < 0) return;
    (void)hipMemsetAsync((char*)d_ws + WS_CTL, 0, CTL_ZERO_BYTES, stream);
    Args a{};
    const float** p = (const float**)&a;
    for (int i = 0; i < 22; ++i) p[i] = (const float*)d_in[i];
    a.out = (float*)d_out; a.ws = (unsigned char*)d_ws;
#if MK_SPLIT
    for (int ph = 0; ph < NPHASE; ++ph) { a.ph_lo = ph; a.ph_hi = ph + 1; hipLaunchKernelGGL(hybrid_fwd, dim3(grid), dim3(NTHR), LDS_BYTES, stream, a); }
#else
    a.ph_lo = 0; a.ph_hi = NPHASE; hipLaunchKernelGGL(hybrid_fwd, dim3(grid), dim3(NTHR), LDS_BYTES, stream, a);
#endif
    const hipError_t le = hipPeekAtLastError();
    if (le != hipSuccess) fprintf(stderr, "kernel_launch: launch failed: %s\n", hipGetErrorName(le));
}
```
